# Optimizing an MI355X kernel written in HIP

```python
import math
import jax, jax.numpy as jnp
from jax import lax
import numpy as np

D_MODEL = 1024
BATCH = 8
SEQ = 4096
DEPTH = 1

CHUNK = 64
N_META = 16
EPS = 1e-6
SSM_WIDTH = D_MODEL // 4
SSM_GROUP = 16
SSM_GROUPS = SSM_WIDTH // SSM_GROUP
SSM_STATE = 64
DT_MIN = 1e-3
DT_MAX = 1e-1
RET_WIDTH = D_MODEL - SSM_WIDTH
RET_HEAD_DIM = 128
RET_HEADS = RET_WIDTH // RET_HEAD_DIM
ROPE_BASE = 10000.0
IN_WIDTH = SSM_WIDTH + 4 * RET_WIDTH
N_GROUPS = 4
EXPERTS_PER_GROUP = 4
N_EXPERTS = N_GROUPS * EXPERTS_PER_GROUP
TOP_K_INNER = 2
EXPERT_FF = D_MODEL // 4

kernel_name = "hymba_s5_retention_hiermoe_streaming"


def rms_norm(x, g):
    xf = x.astype(jnp.float32)
    y = xf * lax.rsqrt(jnp.mean(xf * xf, axis=-1, keepdims=True) + EPS)
    return (y * g.astype(jnp.float32)).astype(x.dtype)


def s5_mixer(u, lam_re, lam_im, log_dt, b_re, b_im, c_re, c_im, d_skip, w_glu):
    bsz, L, _ = u.shape
    f32 = jnp.float32
    uf = u.astype(f32).reshape(bsz, L, SSM_GROUPS, SSM_GROUP)
    lam = lax.complex(lam_re.astype(f32), lam_im.astype(f32))
    dt = jnp.exp(log_dt.astype(f32))[:, None]
    lam_bar = jnp.exp(lam * dt)
    b = lax.complex(b_re.astype(f32), b_im.astype(f32))
    b_bar = ((lam_bar - 1.0) / lam)[..., None] * b
    bu = jnp.einsum('blgh,gph->lbgp', uf.astype(jnp.complex64), b_bar)
    a = jnp.broadcast_to(lam_bar, (L, 1) + lam_bar.shape)

    def combine(e1, e2):
        a1, x1 = e1
        a2, x2 = e2
        return a1 * a2, a2 * x1 + x2

    _, states = lax.associative_scan(combine, (a, bu), axis=0)
    c = lax.complex(c_re.astype(f32), c_im.astype(f32))
    y = jnp.real(jnp.einsum('lbgp,ghp->blgh', states, c)) + d_skip.astype(f32) * uf
    y = jax.nn.gelu(y.reshape(bsz, L, SSM_WIDTH))
    y = y * jax.nn.sigmoid(y @ w_glu.astype(f32))
    return y.astype(u.dtype)


def retention_mixer(q, k, v, gate):
    bsz, L, _ = q.shape
    f32 = jnp.float32
    pos = jnp.arange(L, dtype=f32)
    inv_freq = ROPE_BASE ** (-jnp.arange(0, RET_HEAD_DIM, 2, dtype=f32) / RET_HEAD_DIM)
    ang = pos[:, None] * inv_freq[None, :]
    ang = jnp.concatenate([ang, ang], axis=-1)[:, None, :]
    cos, sin = jnp.cos(ang), jnp.sin(ang)

    def heads(t):
        return t.astype(f32).reshape(bsz, L, RET_HEADS, RET_HEAD_DIM)

    def rope(t):
        t1, t2 = jnp.split(t, 2, axis=-1)
        return t * cos + jnp.concatenate([-t2, t1], axis=-1) * sin

    qh = rope(heads(q))
    kh = rope(heads(k)) * (RET_HEAD_DIM ** -0.5)
    vh = heads(v)

    pad = CHUNK - N_META
    n_chunks = (L + pad) // CHUNK

    def chunks(t):
        t = jnp.pad(t, ((0, 0), (pad, 0), (0, 0), (0, 0)))
        return t.reshape(bsz, n_chunks, CHUNK, RET_HEADS, RET_HEAD_DIM)

    qc, kc, vc = chunks(qh), chunks(kh), chunks(vh)
    gamma = 1.0 - 2.0 ** (-5.0 - jnp.arange(RET_HEADS, dtype=f32))
    log_g = jnp.log(gamma)
    idx = jnp.arange(CHUNK, dtype=f32)
    intra_decay = jnp.exp(log_g[:, None, None] * jnp.abs(idx[:, None] - idx[None, :]))
    scores = jnp.einsum('bnihd,bnjhd->bnhij', qc, kc) * intra_decay
    intra = jnp.einsum('bnhij,bnjhd->bnihd', scores, vc)
    k_decay = jnp.exp(log_g[None, :] * (CHUNK - 1.0 - idx)[:, None])
    kv = jnp.einsum('bnchd,bnche->nbhde', kc * k_decay[:, :, None], vc)
    chunk_decay = jnp.exp(log_g * CHUNK)[None, :, None, None]

    def step(state, kv_n):
        return state * chunk_decay + kv_n, state

    init = jnp.zeros((bsz, RET_HEADS, RET_HEAD_DIM, RET_HEAD_DIM), f32)
    _, r_prev = lax.scan(step, init, kv)
    q_decay = jnp.exp(log_g[None, :] * (idx + 1.0)[:, None])
    cross = jnp.einsum('bnchd,nbhde->bnche', qc * q_decay[:, :, None], r_prev)
    o = (intra + cross).reshape(bsz, n_chunks * CHUNK, RET_HEADS, RET_HEAD_DIM)[:, pad:]
    mu = jnp.mean(o, axis=-1, keepdims=True)
    var = jnp.mean(jnp.square(o - mu), axis=-1, keepdims=True)
    o = ((o - mu) * lax.rsqrt(var + EPS)).reshape(bsz, L, RET_WIDTH)
    return (jax.nn.silu(gate.astype(f32)) * o).astype(q.dtype)


def hier_moe(t, w_rg, b_rg, w_re, b_re, w_gate, w_up, w_down):
    bsz, L, d = t.shape
    f32 = jnp.float32
    tf = t.reshape(-1, d)
    p_g = jax.nn.softmax((tf @ w_rg + b_rg).astype(f32), axis=-1)
    g_w, g_idx = lax.top_k(p_g, 1)
    logits_all = jnp.einsum('td,gde->tge', tf, w_re) + b_re
    logits_e = jnp.take_along_axis(logits_all, g_idx[:, :, None], axis=1)[:, 0].astype(f32)
    e_val, e_idx = lax.top_k(logits_e, TOP_K_INNER)
    e_w = jax.nn.softmax(e_val, axis=-1)
    within = jnp.einsum('tk,tke->te', e_w, jax.nn.one_hot(e_idx, EXPERTS_PER_GROUP, dtype=f32))
    group_sel = jax.nn.one_hot(g_idx[:, 0], N_GROUPS, dtype=f32) * g_w
    combine = (group_sel[:, :, None] * within[:, None, :]).reshape(-1, N_EXPERTS)
    hg = jnp.einsum('td,edf->tef', tf, w_gate)
    hu = jnp.einsum('td,edf->tef', tf, w_up)
    act = jax.nn.silu(hg) * hu * combine.astype(hg.dtype)[:, :, None]
    out = jnp.einsum('tef,efd->td', act, w_down)
    return out.reshape(bsz, L, d).astype(t.dtype)


def setup_inputs(seed: int = 0) -> dict:
    key = jax.random.key(seed)
    ks = jax.random.split(key, 24)
    f32 = jnp.float32
    n = lambda k, s, sc: jax.random.normal(k, s, f32) * sc
    G, P, H = SSM_GROUPS, SSM_STATE, SSM_GROUP
    lam_re = -0.5 + 0.01 * jax.random.normal(ks[3], (DEPTH, G, P), f32)
    lam_im = math.pi * jnp.arange(P, dtype=f32)[None, None, :] + 0.01 * jax.random.normal(ks[4], (DEPTH, G, P), f32)
    log_dt = jax.random.uniform(ks[5], (DEPTH, G), f32, math.log(DT_MIN), math.log(DT_MAX))
    return {
        "x": n(ks[0], (BATCH, SEQ, D_MODEL), 1.0),
        "meta_tokens": n(ks[1], (N_META, D_MODEL), 1.0),
        "norm_mix_g": 1.0 + n(ks[2], (DEPTH, D_MODEL), 0.02),
        "w_in": n(ks[6], (DEPTH, D_MODEL, IN_WIDTH), D_MODEL ** -0.5),
        "ssm_lambda_re": lam_re,
        "ssm_lambda_im": lam_im,
        "ssm_log_dt": log_dt,
        "ssm_b_re": n(ks[7], (DEPTH, G, P, H), (2 * H) ** -0.5),
        "ssm_b_im": n(ks[8], (DEPTH, G, P, H), (2 * H) ** -0.5),
        "ssm_c_re": n(ks[9], (DEPTH, G, H, P), (2 * P) ** -0.5),
        "ssm_c_im": n(ks[10], (DEPTH, G, H, P), (2 * P) ** -0.5),
        "ssm_d": n(ks[11], (DEPTH, G, H), 1.0),
        "w_glu": n(ks[12], (DEPTH, SSM_WIDTH, SSM_WIDTH), SSM_WIDTH ** -0.5),
        "w_out": n(ks[13], (DEPTH, D_MODEL, D_MODEL), D_MODEL ** -0.5),
        "norm_ffn_g": 1.0 + n(ks[14], (DEPTH, D_MODEL), 0.02),
        "w_router_group": n(ks[15], (DEPTH, D_MODEL, N_GROUPS), D_MODEL ** -0.5),
        "b_router_group": n(ks[16], (DEPTH, N_GROUPS), 0.01),
        "w_router_expert": n(ks[17], (DEPTH, N_GROUPS, D_MODEL, EXPERTS_PER_GROUP), D_MODEL ** -0.5),
        "b_router_expert": n(ks[18], (DEPTH, N_GROUPS, EXPERTS_PER_GROUP), 0.01),
        "w_gate": n(ks[19], (DEPTH, N_EXPERTS, D_MODEL, EXPERT_FF), D_MODEL ** -0.5),
        "w_up": n(ks[20], (DEPTH, N_EXPERTS, D_MODEL, EXPERT_FF), D_MODEL ** -0.5),
        "w_down": n(ks[21], (DEPTH, N_EXPERTS, EXPERT_FF, D_MODEL), EXPERT_FF ** -0.5),
        "norm_final_g": 1.0 + n(ks[22], (D_MODEL,), 0.02),
    }


def reference(x, meta_tokens, norm_mix_g, w_in, ssm_lambda_re, ssm_lambda_im, ssm_log_dt,
              ssm_b_re, ssm_b_im, ssm_c_re, ssm_c_im, ssm_d, w_glu, w_out, norm_ffn_g,
              w_router_group, b_router_group, w_router_expert, b_router_expert,
              w_gate, w_up, w_down, norm_final_g):
    bsz = x.shape[0]
    meta = jnp.broadcast_to(meta_tokens[None].astype(x.dtype), (bsz, N_META, D_MODEL))
    h = jnp.concatenate([meta, x], axis=1)
    splits = [SSM_WIDTH, SSM_WIDTH + RET_WIDTH, SSM_WIDTH + 2 * RET_WIDTH, SSM_WIDTH + 3 * RET_WIDTH]
    for layer in range(DEPTH):
        a = rms_norm(h, norm_mix_g[layer])
        z = a @ w_in[layer]
        u, q, k, v, g = jnp.split(z, splits, axis=-1)
        y_ssm = s5_mixer(u, ssm_lambda_re[layer], ssm_lambda_im[layer], ssm_log_dt[layer],
                         ssm_b_re[layer], ssm_b_im[layer], ssm_c_re[layer], ssm_c_im[layer],
                         ssm_d[layer], w_glu[layer])
        y_ret = retention_mixer(q, k, v, g)
        mixed = jnp.concatenate([y_ssm, y_ret], axis=-1)
        h = h + (mixed @ w_out[layer]).astype(h.dtype)
        h = h + hier_moe(rms_norm(h, norm_ffn_g[layer]), w_router_group[layer], b_router_group[layer],
                         w_router_expert[layer], b_router_expert[layer],
                         w_gate[layer], w_up[layer], w_down[layer])
    return rms_norm(h, norm_final_g)[:, N_META:]
```

```cpp
#include <hip/hip_runtime.h>
#include <stdint.h>

#define T_REAL 32768
#define SEQ 4096
#define NBATCH 8
#define DM 1024
#define NIN 3328
#define NMETA 16
#define MROWS (T_REAL + NMETA)
#define EPS 1e-6f
#define ZU 0
#define ZQ 256
#define ZK 1024
#define ZV 1792
#define ZG 2560

typedef unsigned short bf16_t;
__device__ __forceinline__ float bf2f(bf16_t b) { return __uint_as_float(((unsigned)b) << 16); }
__device__ __forceinline__ bf16_t f2bf(float f) { unsigned u = __float_as_uint(f); u += 0x7fffu + ((u >> 16) & 1u); return (bf16_t)(u >> 16); }

__constant__ double c_invfreq[64] = {1.0, 0.8659643233600653, 0.7498942093324559, 0.6493816315762113, 0.5623413251903491, 0.4869675251658631, 0.4216965034285822, 0.3651741272548377, 0.31622776601683794, 0.27384196342643613, 0.23713737056616552, 0.2053525026457146, 0.1778279410038923, 0.1539926526059492, 0.1333521432163324, 0.11547819846894582, 0.1, 0.08659643233600653, 0.07498942093324558, 0.06493816315762113, 0.05623413251903491, 0.04869675251658631, 0.042169650342858224, 0.03651741272548377, 0.03162277660168379, 0.027384196342643614, 0.023713737056616554, 0.02053525026457146, 0.01778279410038923, 0.01539926526059492, 0.01333521432163324, 0.011547819846894581, 0.01, 0.008659643233600654, 0.007498942093324558, 0.006493816315762113, 0.005623413251903491, 0.004869675251658631, 0.004216965034285823, 0.003651741272548377, 0.0031622776601683794, 0.0027384196342643613, 0.0023713737056616554, 0.002053525026457146, 0.0017782794100389228, 0.001539926526059492, 0.001333521432163324, 0.0011547819846894581, 0.001, 0.0008659643233600654, 0.0007498942093324559, 0.0006493816315762113, 0.0005623413251903491, 0.0004869675251658631, 0.00042169650342858224, 0.0003651741272548377, 0.00031622776601683794, 0.0002738419634264361, 0.00023713737056616554, 0.0002053525026457146, 0.00017782794100389227, 0.0001539926526059492, 0.0001333521432163324, 0.00011547819846894582};

__device__ __forceinline__ float wave_sum(float v) {
#pragma unroll
    for (int o = 1; o < 64; o <<= 1) v += __shfl_xor(v, o);
    return v;
}

__global__ __launch_bounds__(256) void k_rstd(const float* x, const float* meta, float* rstd) {
    const int row = blockIdx.x * 4 + (threadIdx.x >> 6), lane = threadIdx.x & 63;
    if (row >= MROWS) return;
    const float* p = row < T_REAL ? x + (size_t)row * DM : meta + (size_t)(row - T_REAL) * DM;
    float s = 0.f;
#pragma unroll
    for (int j = 0; j < 4; ++j) { float4 v = *(const float4*)(p + lane * 4 + 256 * j); s += v.x * v.x + v.y * v.y + v.z * v.z + v.w * v.w; }
    s = wave_sum(s);
    if (lane == 0) rstd[row] = rsqrtf(s * (1.0f / DM) + EPS);
}

enum { EPI_Z = 0, EPI_GLU = 1, EPI_H1 = 2 };
struct GemmP { const float* A; const float* B; const float* ascale; const float* rowscale; const float* aux; void* C; int lda, ldb, M, N, K, ldc, crow0, ldaux; };
template <int EPI> __global__ __launch_bounds__(256) void k_gemm(GemmP p) {
    __shared__ float As[16][132];
    __shared__ float Bs[16][132];
    const int tid = threadIdx.x, tx = tid & 15, ty = tid >> 4;
    const int m0 = blockIdx.y * 128, n0 = blockIdx.x * 128;
    float acc[8][8];
#pragma unroll
    for (int i = 0; i < 8; ++i)
#pragma unroll
        for (int j = 0; j < 8; ++j) acc[i][j] = 0.f;
    for (int k0 = 0; k0 < p.K; k0 += 16) {
        {
            const int r = tid >> 1, kk = (tid & 1) * 8; int gm = m0 + r; if (gm >= p.M) gm = p.M - 1;
            const float* ap = p.A + (size_t)gm * p.lda + k0 + kk;
            float4 a0 = *(const float4*)ap, a1 = *(const float4*)(ap + 4);
            if (p.ascale) { const float4 s0 = *(const float4*)(p.ascale + k0 + kk), s1 = *(const float4*)(p.ascale + k0 + kk + 4);
                a0.x *= s0.x; a0.y *= s0.y; a0.z *= s0.z; a0.w *= s0.w; a1.x *= s1.x; a1.y *= s1.y; a1.z *= s1.z; a1.w *= s1.w; }
            As[kk + 0][r] = a0.x; As[kk + 1][r] = a0.y; As[kk + 2][r] = a0.z; As[kk + 3][r] = a0.w;
            As[kk + 4][r] = a1.x; As[kk + 5][r] = a1.y; As[kk + 6][r] = a1.z; As[kk + 7][r] = a1.w;
        }
        {
            const int kk = tid >> 4, nn = (tid & 15) * 8;
            const float* bp = p.B + (size_t)(k0 + kk) * p.ldb + n0 + nn;
            const float4 b0 = *(const float4*)bp, b1 = *(const float4*)(bp + 4);
            *(float4*)&Bs[kk][nn] = b0; *(float4*)&Bs[kk][nn + 4] = b1;
        }
        __syncthreads();
#pragma unroll
        for (int kk = 0; kk < 16; ++kk) {
            const float4 a0 = *(const float4*)&As[kk][ty * 8], a1 = *(const float4*)&As[kk][ty * 8 + 4];
            const float4 b0 = *(const float4*)&Bs[kk][tx * 8], b1 = *(const float4*)&Bs[kk][tx * 8 + 4];
            const float a[8] = {a0.x, a0.y, a0.z, a0.w, a1.x, a1.y, a1.z, a1.w};
            const float b[8] = {b0.x, b0.y, b0.z, b0.w, b1.x, b1.y, b1.z, b1.w};
#pragma unroll
            for (int i = 0; i < 8; ++i)
#pragma unroll
                for (int j = 0; j < 8; ++j) acc[i][j] = fmaf(a[i], b[j], acc[i][j]);
        }
        __syncthreads();
    }
#pragma unroll
    for (int i = 0; i < 8; ++i) {
        const int gm = m0 + ty * 8 + i;
        if (gm < p.M) {
#pragma unroll
            for (int j = 0; j < 8; ++j) {
                const int gn = n0 + tx * 8 + j;
                const float v = acc[i][j];
                if (EPI == EPI_Z) { ((bf16_t*)p.C)[(size_t)(p.crow0 + gm) * p.ldc + gn] = f2bf(v * p.rowscale[p.crow0 + gm]); }
                else if (EPI == EPI_GLU) { const float y = p.aux[(size_t)gm * p.ldaux + gn]; ((float*)p.C)[(size_t)gm * p.ldc + gn] = y / (1.0f + expf(-v)); }
                else { ((float*)p.C)[(size_t)gm * p.ldc + gn] = p.aux[(size_t)gm * p.ldaux + gn] + v; }
            }
        }
    }
}

__global__ __launch_bounds__(256) void k_rope(bf16_t* Z) {
    const int row = blockIdx.x * 4 + (threadIdx.x >> 6), i = threadIdx.x & 63;
    if (row >= MROWS) return;
    const int pos = row < T_REAL ? NMETA + (row & (SEQ - 1)) : row - T_REAL;
    const double ang = (double)pos * c_invfreq[i];
    const double red = ang - 6.283185307179586476925 * rint(ang * 0.15915494309189533577);
    float sn, cs; sincosf((float)red, &sn, &cs);
    bf16_t* z = Z + (size_t)row * NIN;
#pragma unroll
    for (int h = 0; h < 6; ++h) {
        { bf16_t* q = z + ZQ + h * 128; const float t1 = bf2f(q[i]), t2 = bf2f(q[i + 64]); q[i] = f2bf(t1 * cs - t2 * sn); q[i + 64] = f2bf(t2 * cs + t1 * sn); }
        { bf16_t* k = z + ZK + h * 128; const float t1 = bf2f(k[i]), t2 = bf2f(k[i + 64]); const float sc = 0.08838834764831845f; k[i] = f2bf((t1 * cs - t2 * sn) * sc); k[i + 64] = f2bf((t2 * cs + t1 * sn) * sc); }
    }
}

__global__ __launch_bounds__(64) void k_s5_pw(const float* lre, const float* lim, const float* ldt, const float* bre, const float* bim, double2* pw, float2* bb) {
    const int g = blockIdx.x, p = threadIdx.x;
    const float re = lre[g * 64 + p], im = lim[g * 64 + p], dt = expf(ldt[g]);
    const float a = re * dt;
    const double th_d = (double)im * (double)dt;
    const float th = (float)(th_d - 6.283185307179586476925 * rint(th_d * 0.15915494309189533577));
    const float ea = expf(a), em1 = expm1f(a);
    float sn, cs; sincosf(th, &sn, &cs);
    const float sh = sinf(0.5f * th);
    const float lbr = ea * cs, lbi = ea * sn;
    const float mr = em1 * cs - 2.f * sh * sh, mi = ea * sn;
    const float den = re * re + im * im;
    const float fr = (mr * re + mi * im) / den, fi = (mi * re - mr * im) / den;
    for (int h = 0; h < 16; ++h) { const float br = bre[(g * 64 + p) * 16 + h], bi = bim[(g * 64 + p) * 16 + h]; bb[(g * 64 + p) * 16 + h] = make_float2(fr * br - fi * bi, fr * bi + fi * br); }
    double xr = 1.0, xi = 0.0;
    for (int d = 0; d <= 64; ++d) { pw[(g * 65 + d) * 64 + p] = make_double2(xr, xi); const double nr = xr * lbr - xi * lbi, ni = xr * lbi + xi * lbr; xr = nr; xi = ni; }
}
__global__ __launch_bounds__(256) void k_s5_tables(const float* cre, const float* cim, const float* dsk, const double2* pw, const float2* bb, float* Kd, float2* CL, float2* BL) {
    const int g = blockIdx.x >> 6, d = blockIdx.x & 63, h = threadIdx.x >> 4, h2 = threadIdx.x & 15;
    float s = 0.f;
    for (int p = 0; p < 64; ++p) {
        const double2 w = pw[(g * 65 + d) * 64 + p]; const float cr = cre[(g * 16 + h) * 64 + p], ci = cim[(g * 16 + h) * 64 + p];
        const float2 b = bb[(g * 64 + p) * 16 + h2];
        const float tr = (float)(cr * w.x - ci * w.y), ti = (float)(cr * w.y + ci * w.x);
        s += tr * b.x - ti * b.y;
    }
    if (d == 0 && h == h2) s += dsk[g * 16 + h];
    Kd[((g * 64 + d) * 16 + h) * 16 + h2] = s;
    for (int p = h2; p < 64; p += 16) {
        const double2 w = pw[(g * 65 + d + 1) * 64 + p]; const float cr = cre[(g * 16 + h) * 64 + p], ci = cim[(g * 16 + h) * 64 + p];
        CL[((g * 64 + d) * 16 + h) * 64 + p] = make_float2((float)(cr * w.x - ci * w.y), (float)(cr * w.y + ci * w.x));
    }
    for (int q = 0; q < 4; ++q) { const int p = h * 4 + q; const double2 w = pw[(g * 65 + (63 - d)) * 64 + p]; const float2 b = bb[(g * 64 + p) * 16 + h2];
        BL[((g * 64 + d) * 64 + p) * 16 + h2] = make_float2((float)(w.x * b.x - w.y * b.y), (float)(w.x * b.y + w.y * b.x)); }
}
__global__ __launch_bounds__(512) void k_s5_loc(const bf16_t* Z, const float2* BL, float2* loc, float2* locmeta) {
    __shared__ float us[8][64][16];
    const int n = blockIdx.x, g = blockIdx.y, b = threadIdx.x >> 6, p = threadIdx.x & 63;
    const int ntok = n < 64 ? 64 : 16, j0 = n < 64 ? 0 : 48;
    for (int e = threadIdx.x; e < 8 * 64 * 16; e += 512) {
        const int bb_ = e >> 10, j = (e >> 4) & 63, h = e & 15; float v = 0.f;
        if (j < ntok) { const size_t row = n < 64 ? (size_t)bb_ * SEQ + n * 64 + j : (size_t)T_REAL + j; v = bf2f(Z[row * NIN + ZU + g * 16 + h]); }
        us[bb_][j][h] = v;
    }
    __syncthreads();
    float sr = 0.f, si = 0.f;
    for (int j = 0; j < ntok; ++j) {
        const float2* bl = BL + ((size_t)(g * 64 + j0 + j) * 64 + p) * 16;
#pragma unroll
        for (int h = 0; h < 16; ++h) { const float2 w = bl[h]; const float u = us[b][j][h]; sr = fmaf(w.x, u, sr); si = fmaf(w.y, u, si); }
    }
    if (n < 64) loc[(((size_t)b * 64 + n) * 16 + g) * 64 + p] = make_float2(sr, si);
    else if (b == 0) locmeta[g * 64 + p] = make_float2(sr, si);
}
__global__ __launch_bounds__(64) void k_s5_scan(const float2* loc, const float2* locmeta, const double2* pw, float2* X) {
    const int b = blockIdx.x >> 4, g = blockIdx.x & 15, p = threadIdx.x;
    const double2 wC = pw[(g * 65 + 64) * 64 + p]; const float lr = (float)wC.x, li = (float)wC.y;
    float2 x = locmeta[g * 64 + p];
    for (int n = 0; n < 64; ++n) {
        const size_t idx = (((size_t)b * 64 + n) * 16 + g) * 64 + p;
        X[idx] = x; const float2 l = loc[idx];
        const float nr = lr * x.x - li * x.y + l.x, ni = lr * x.y + li * x.x + l.y; x.x = nr; x.y = ni;
    }
}
__device__ __forceinline__ float gelu_tanh(float x) { const float t = tanhf(0.7978845608028654f * (x + 0.044715f * x * x * x)); return 0.5f * x * (1.f + t); }
__global__ __launch_bounds__(1024) void k_s5_out(const bf16_t* Z, const float* Kd, const float2* CL, const float2* X, float* Y) {
    extern __shared__ float sm[];
    float* kd = sm;
    float* us = sm + 64 * 256;
    float2* xs = (float2*)(us + 64 * 16);
    const int bn = blockIdx.x, g = blockIdx.y, i = threadIdx.x >> 4, h = threadIdx.x & 15;
    for (int e = threadIdx.x; e < 64 * 256; e += 1024) kd[e] = Kd[(size_t)g * 64 * 256 + e];
    { const int j = threadIdx.x >> 4, hh = threadIdx.x & 15; us[j * 16 + hh] = bf2f(Z[((size_t)bn * 64 + j) * NIN + ZU + g * 16 + hh]); }
    if (threadIdx.x < 64) xs[threadIdx.x] = X[((size_t)bn * 16 + g) * 64 + threadIdx.x];
    __syncthreads();
    float s = 0.f;
    const float2* cl = CL + ((size_t)(g * 64 + i) * 16 + h) * 64;
    for (int p = 0; p < 64; ++p) { const float2 c = cl[p], x = xs[p]; s += c.x * x.x - c.y * x.y; }
    for (int j = 0; j <= i; ++j) {
        const float* k = kd + ((i - j) * 16 + h) * 16; const float* u = us + j * 16;
#pragma unroll
        for (int q = 0; q < 16; ++q) s = fmaf(k[q], u[q], s);
    }
    Y[((size_t)bn * 64 + i) * 256 + g * 16 + h] = gelu_tanh(s);
}

__device__ __forceinline__ float gamma_of(int h) { return 1.0f - exp2f(-5.0f - (float)h); }
__global__ __launch_bounds__(256) void k_ret_kvloc(const bf16_t* Z, float* KV) {
    __shared__ float ks[32][128];
    __shared__ float vs[32][128];
    const int item = blockIdx.x; int h, ntok; size_t row0;
    if (item < 768) { const int S = item & 15, bh = item >> 4; h = bh % 6; const int b = bh / 6; ntok = 256; row0 = (size_t)b * SEQ + S * 256; }
    else { h = item - 768; ntok = 16; row0 = T_REAL; }
    const float lg = log2f(gamma_of(h));
    const int tid = threadIdx.x, td = tid >> 4, te = tid & 15;
    float acc[8][8];
#pragma unroll
    for (int i = 0; i < 8; ++i)
#pragma unroll
        for (int j = 0; j < 8; ++j) acc[i][j] = 0.f;
    for (int j0 = 0; j0 < ntok; j0 += 32) {
        const int nj = (ntok - j0) < 32 ? (ntok - j0) : 32;
        for (int e = tid; e < 32 * 128; e += 256) {
            const int j = e >> 7, c = e & 127; float kv_ = 0.f, vv = 0.f;
            if (j < nj) { const bf16_t* z = Z + (row0 + j0 + j) * NIN; kv_ = bf2f(z[ZK + h * 128 + c]) * exp2f(lg * (float)(ntok - 1 - (j0 + j))); vv = bf2f(z[ZV + h * 128 + c]); }
            ks[j][c] = kv_; vs[j][c] = vv;
        }
        __syncthreads();
        for (int j = 0; j < nj; ++j) {
            float a[8], b[8];
#pragma unroll
            for (int i = 0; i < 8; ++i) { a[i] = ks[j][td * 8 + i]; b[i] = vs[j][te * 8 + i]; }
#pragma unroll
            for (int i = 0; i < 8; ++i)
#pragma unroll
                for (int q = 0; q < 8; ++q) acc[i][q] = fmaf(a[i], b[q], acc[i][q]);
        }
        __syncthreads();
    }
    float* o = KV + (size_t)item * 16384;
#pragma unroll
    for (int i = 0; i < 8; ++i)
#pragma unroll
        for (int q = 0; q < 8; ++q) o[(td * 8 + i) * 128 + te * 8 + q] = acc[i][q];
}
__global__ __launch_bounds__(256) void k_ret_scan(float* KV) {
    const int bh = blockIdx.x >> 6, e = (blockIdx.x & 63) * 256 + threadIdx.x, h = bh % 6;
    const float g256 = exp2f(256.f * log2f(gamma_of(h)));
    float r = KV[(size_t)(768 + h) * 16384 + e];
    for (int S = 0; S < 16; ++S) { float* p = KV + (size_t)(bh * 16 + S) * 16384 + e; const float l = *p; *p = r; r = g256 * r + l; }
}
__global__ __launch_bounds__(256) void k_ret_out(const bf16_t* Z, const float* KV, float* mixed) {
    extern __shared__ float sm[];
    float* qs = sm; float* ks = qs + 64 * 129; float* vs = ks + 64 * 129; float* ss = vs + 64 * 128;
    const int n = blockIdx.x & 63, bh = blockIdx.x >> 6, h = bh % 6, b = bh / 6, tid = threadIdx.x;
    const float lg = log2f(gamma_of(h));
    const size_t rowq = (size_t)b * SEQ + n * 64;
    for (int e = tid; e < 64 * 128; e += 256) { const int i = e >> 7, c = e & 127; qs[i * 129 + c] = bf2f(Z[(rowq + i) * NIN + ZQ + h * 128 + c]); }
    const int i0 = (tid >> 4) * 4, e0 = (tid & 15) * 8;
    float acc[4][8];
#pragma unroll
    for (int i = 0; i < 4; ++i)
#pragma unroll
        for (int q = 0; q < 8; ++q) acc[i][q] = 0.f;
    const int nq = n & 3;
    for (int kb = 0; kb <= nq; ++kb) {
        const size_t rowk = (size_t)b * SEQ + (n - nq + kb) * 64;
        __syncthreads();
        for (int e = tid; e < 64 * 128; e += 256) { const int j = e >> 7, c = e & 127; const bf16_t* z = Z + (rowk + j) * NIN; ks[j * 129 + c] = bf2f(z[ZK + h * 128 + c]); vs[j * 128 + c] = bf2f(z[ZV + h * 128 + c]); }
        __syncthreads();
        {
            const int i = tid >> 2, jb = (tid & 3) * 16; float sc[16];
#pragma unroll
            for (int j = 0; j < 16; ++j) sc[j] = 0.f;
            for (int d = 0; d < 128; ++d) { const float qv = qs[i * 129 + d];
#pragma unroll
                for (int j = 0; j < 16; ++j) sc[j] = fmaf(qv, ks[(jb + j) * 129 + d], sc[j]); }
            const int dist0 = (nq - kb) * 64;
#pragma unroll
            for (int j = 0; j < 16; ++j) { const int jj = jb + j; const int dd = (kb == nq) ? (i > jj ? i - jj : jj - i) : dist0 + i - jj; ss[i * 65 + jj] = sc[j] * exp2f(lg * (float)dd); }
        }
        __syncthreads();
        for (int j = 0; j < 64; ++j) {
            float vv[8];
#pragma unroll
            for (int q = 0; q < 8; ++q) vv[q] = vs[j * 128 + e0 + q];
#pragma unroll
            for (int i = 0; i < 4; ++i) { const float s = ss[(i0 + i) * 65 + j];
#pragma unroll
                for (int q = 0; q < 8; ++q) acc[i][q] = fmaf(s, vv[q], acc[i][q]); }
        }
    }
    {
        const float* R = KV + (size_t)(bh * 16 + (n >> 2)) * 16384;
        float cr[4][8];
#pragma unroll
        for (int i = 0; i < 4; ++i)
#pragma unroll
            for (int q = 0; q < 8; ++q) cr[i][q] = 0.f;
        for (int d = 0; d < 128; ++d) {
            const float4 r0 = *(const float4*)(R + d * 128 + e0), r1 = *(const float4*)(R + d * 128 + e0 + 4);
            const float rr[8] = {r0.x, r0.y, r0.z, r0.w, r1.x, r1.y, r1.z, r1.w};
#pragma unroll
            for (int i = 0; i < 4; ++i) { const float qv = qs[(i0 + i) * 129 + d];
#pragma unroll
                for (int q = 0; q < 8; ++q) cr[i][q] = fmaf(qv, rr[q], cr[i][q]); }
        }
#pragma unroll
        for (int i = 0; i < 4; ++i) { const float dc = exp2f(lg * (float)(i0 + i + 1 + 64 * nq));
#pragma unroll
            for (int q = 0; q < 8; ++q) acc[i][q] = fmaf(dc, cr[i][q], acc[i][q]); }
    }
#pragma unroll
    for (int i = 0; i < 4; ++i) {
        float s = 0.f;
#pragma unroll
        for (int q = 0; q < 8; ++q) s += acc[i][q];
#pragma unroll
        for (int o = 1; o < 16; o <<= 1) s += __shfl_xor(s, o);
        const float mu = s * (1.f / 128.f); float v = 0.f;
#pragma unroll
        for (int q = 0; q < 8; ++q) { const float dlt = acc[i][q] - mu; v += dlt * dlt; }
#pragma unroll
        for (int o = 1; o < 16; o <<= 1) v += __shfl_xor(v, o);
        const float rs = rsqrtf(v * (1.f / 128.f) + EPS);
        const size_t row = rowq + i0 + i;
#pragma unroll
        for (int q = 0; q < 8; ++q) { const float gt = bf2f(Z[row * NIN + ZG + h * 128 + e0 + q]); const float sl = gt / (1.f + expf(-gt)); mixed[row * DM + 256 + h * 128 + e0 + q] = sl * (acc[i][q] - mu) * rs; }
    }
}

struct Route { int e1, e2; float w1, w2; };
__global__ __launch_bounds__(256) void k_router(const float* h1, const float* gff, const float* wrg, const float* brg, const float* wre, const float* bre, Route* route, float* rstd2) {
    const int t = blockIdx.x * 4 + (threadIdx.x >> 6), lane = threadIdx.x & 63;
    const float* hp = h1 + (size_t)t * DM;
    float a[16]; float ss = 0.f;
#pragma unroll
    for (int j = 0; j < 4; ++j) { const float4 v = *(const float4*)(hp + lane * 4 + 256 * j); a[4 * j] = v.x; a[4 * j + 1] = v.y; a[4 * j + 2] = v.z; a[4 * j + 3] = v.w; ss += v.x * v.x + v.y * v.y + v.z * v.z + v.w * v.w; }
    ss = wave_sum(ss);
    const float rs = rsqrtf(ss * (1.f / DM) + EPS);
#pragma unroll
    for (int j = 0; j < 4; ++j) { const float4 gv = *(const float4*)(gff + lane * 4 + 256 * j); a[4 * j] *= rs * gv.x; a[4 * j + 1] *= rs * gv.y; a[4 * j + 2] *= rs * gv.z; a[4 * j + 3] *= rs * gv.w; }
    float lg[4] = {0.f, 0.f, 0.f, 0.f}, le[4][4];
#pragma unroll
    for (int g = 0; g < 4; ++g)
#pragma unroll
        for (int e = 0; e < 4; ++e) le[g][e] = 0.f;
#pragma unroll
    for (int j = 0; j < 4; ++j)
#pragma unroll
        for (int i = 0; i < 4; ++i) {
            const int k = lane * 4 + 256 * j + i; const float av = a[4 * j + i];
            const float4 w = *(const float4*)(wrg + (size_t)k * 4);
            lg[0] = fmaf(av, w.x, lg[0]); lg[1] = fmaf(av, w.y, lg[1]); lg[2] = fmaf(av, w.z, lg[2]); lg[3] = fmaf(av, w.w, lg[3]);
#pragma unroll
            for (int g = 0; g < 4; ++g) { const float4 we = *(const float4*)(wre + ((size_t)g * DM + k) * 4);
                le[g][0] = fmaf(av, we.x, le[g][0]); le[g][1] = fmaf(av, we.y, le[g][1]); le[g][2] = fmaf(av, we.z, le[g][2]); le[g][3] = fmaf(av, we.w, le[g][3]); }
        }
#pragma unroll
    for (int g = 0; g < 4; ++g) { lg[g] = wave_sum(lg[g]) + brg[g];
#pragma unroll
        for (int e = 0; e < 4; ++e) le[g][e] = wave_sum(le[g][e]); }
    if (lane == 0) {
        int gi = 0; float gm = lg[0];
#pragma unroll
        for (int g = 1; g < 4; ++g) if (lg[g] > gm) { gm = lg[g]; gi = g; }
        float den = 0.f;
#pragma unroll
        for (int g = 0; g < 4; ++g) den += expf(lg[g] - gm);
        const float gw = 1.f / den;
        float v[4];
#pragma unroll
        for (int e = 0; e < 4; ++e) { float x = le[0][e]; if (gi == 1) x = le[1][e]; if (gi == 2) x = le[2][e]; if (gi == 3) x = le[3][e]; v[e] = x + bre[gi * 4 + e]; }
        int i1 = 0; float m1 = v[0];
#pragma unroll
        for (int e = 1; e < 4; ++e) if (v[e] > m1) { m1 = v[e]; i1 = e; }
        int i2 = -1; float m2 = -3.0e38f;
#pragma unroll
        for (int e = 0; e < 4; ++e) if (e != i1 && v[e] > m2) { m2 = v[e]; i2 = e; }
        const float w1 = 1.f / (1.f + expf(m2 - m1)), w2 = 1.f - w1;
        Route r; r.e1 = gi * 4 + i1; r.e2 = gi * 4 + i2; r.w1 = gw * w1; r.w2 = gw * w2; route[t] = r; rstd2[t] = rs;
    }
}
__global__ __launch_bounds__(256) void k_moe_h(const float* h1, const float* gff, const float* rstd2, const Route* route, const float* wg, const float* wu, float* H) {
    __shared__ float as[DM];
    const int t = blockIdx.x >> 1, slot = blockIdx.x & 1, f = threadIdx.x;
    const Route r = route[t]; const int e = slot ? r.e2 : r.e1; const float w = slot ? r.w2 : r.w1; const float rs = rstd2[t];
    for (int k = f; k < DM; k += 256) as[k] = h1[(size_t)t * DM + k] * rs * gff[k];
    __syncthreads();
    const float* pg = wg + (size_t)e * DM * 256 + f; const float* pu = wu + (size_t)e * DM * 256 + f;
    float g = 0.f, u = 0.f;
#pragma unroll 8
    for (int k = 0; k < DM; ++k) { const float av = as[k]; g = fmaf(av, pg[(size_t)k * 256], g); u = fmaf(av, pu[(size_t)k * 256], u); }
    H[((size_t)t * 2 + slot) * 256 + f] = g / (1.f + expf(-g)) * u * w;
}
__global__ __launch_bounds__(256) void k_moe_down(float* h1out, const float* H, const Route* route, const float* wd, const float* gfin) {
    __shared__ float hs[512];
    __shared__ float red[4];
    const int t = blockIdx.x, tid = threadIdx.x;
    const Route r = route[t];
    hs[tid] = H[(size_t)t * 512 + tid]; hs[tid + 256] = H[(size_t)t * 512 + 256 + tid];
    float4 acc = *(const float4*)(h1out + (size_t)t * DM + tid * 4);
    __syncthreads();
#pragma unroll
    for (int slot = 0; slot < 2; ++slot) {
        const int e = slot ? r.e2 : r.e1; const float* w = wd + (size_t)e * 256 * DM + tid * 4;
#pragma unroll 8
        for (int f = 0; f < 256; ++f) { const float hv = hs[slot * 256 + f]; const float4 wv = *(const float4*)(w + (size_t)f * DM);
            acc.x = fmaf(hv, wv.x, acc.x); acc.y = fmaf(hv, wv.y, acc.y); acc.z = fmaf(hv, wv.z, acc.z); acc.w = fmaf(hv, wv.w, acc.w); }
    }
    float ss = acc.x * acc.x + acc.y * acc.y + acc.z * acc.z + acc.w * acc.w;
    ss = wave_sum(ss);
    if ((tid & 63) == 0) red[tid >> 6] = ss;
    __syncthreads();
    const float rs = rsqrtf((red[0] + red[1] + red[2] + red[3]) * (1.f / DM) + EPS);
    const float4 gv = *(const float4*)(gfin + tid * 4);
    float4 o; o.x = acc.x * rs * gv.x; o.y = acc.y * rs * gv.y; o.z = acc.z * rs * gv.z; o.w = acc.w * rs * gv.w;
    *(float4*)(h1out + (size_t)t * DM + tid * 4) = o;
}

extern "C" void kernel_launch(void* const* d_in, const int* in_sizes, int n_in, void* d_out, int out_size, void* d_ws, size_t ws_size, hipStream_t stream) {
    const float* x = (const float*)d_in[0]; const float* meta = (const float*)d_in[1]; const float* gmix = (const float*)d_in[2]; const float* w_in = (const float*)d_in[3];
    const float* lre = (const float*)d_in[4]; const float* lim = (const float*)d_in[5]; const float* ldt = (const float*)d_in[6];
    const float* bre = (const float*)d_in[7]; const float* bim = (const float*)d_in[8]; const float* cre = (const float*)d_in[9]; const float* cim = (const float*)d_in[10];
    const float* dsk = (const float*)d_in[11]; const float* w_glu = (const float*)d_in[12]; const float* w_out = (const float*)d_in[13]; const float* gffn = (const float*)d_in[14];
    const float* wrg = (const float*)d_in[15]; const float* brg = (const float*)d_in[16]; const float* wre = (const float*)d_in[17]; const float* bre2 = (const float*)d_in[18];
    const float* wgate = (const float*)d_in[19]; const float* wup = (const float*)d_in[20]; const float* wdown = (const float*)d_in[21]; const float* gfin = (const float*)d_in[22];
    float* out = (float*)d_out;
    unsigned char* ws = (unsigned char*)d_ws; size_t off = 0;
    auto take = [&](size_t bytes) { unsigned char* p = ws + off; off += (bytes + 255) & ~(size_t)255; return p; };
    bf16_t* Z = (bf16_t*)take((size_t)MROWS * NIN * 2);
    float* rstd1 = (float*)take((size_t)MROWS * 4);
    double2* pw = (double2*)take((size_t)16 * 65 * 64 * 16);
    float2* bb = (float2*)take((size_t)16 * 64 * 16 * 8);
    float* Kd = (float*)take((size_t)16 * 64 * 256 * 4);
    float2* CL = (float2*)take((size_t)16 * 64 * 16 * 64 * 8);
    float2* BL = (float2*)take((size_t)16 * 64 * 64 * 16 * 8);
    float2* loc = (float2*)take((size_t)8 * 64 * 16 * 64 * 8);
    float2* locmeta = (float2*)take((size_t)16 * 64 * 8);
    float2* X = (float2*)take((size_t)8 * 64 * 16 * 64 * 8);
    float* Y = (float*)take((size_t)T_REAL * 256 * 4);
    float* mixed = (float*)take((size_t)T_REAL * DM * 4);
    float* KV = (float*)take((size_t)774 * 16384 * 4);
    Route* route = (Route*)take((size_t)T_REAL * 16);
    float* rstd2 = (float*)take((size_t)T_REAL * 4);
    float* H = (float*)Z;
    (void)ws_size; (void)in_sizes; (void)n_in; (void)out_size;
    static bool attr_done = false;
    if (!attr_done) { (void)hipFuncSetAttribute((const void*)k_s5_out, hipFuncAttributeMaxDynamicSharedMemorySize, (64 * 256 + 64 * 16 + 128) * 4);
        (void)hipFuncSetAttribute((const void*)k_ret_out, hipFuncAttributeMaxDynamicSharedMemorySize, (64 * 129 * 2 + 64 * 128 + 64 * 65) * 4); attr_done = true; }

    hipLaunchKernelGGL(k_rstd, dim3((MROWS + 3) / 4), dim3(256), 0, stream, x, meta, rstd1);
    { GemmP p{}; p.A = x; p.lda = DM; p.B = w_in; p.ldb = NIN; p.M = T_REAL; p.N = NIN; p.K = DM; p.ascale = gmix; p.rowscale = rstd1; p.C = Z; p.ldc = NIN; p.crow0 = 0; p.aux = nullptr; p.ldaux = 0;
      hipLaunchKernelGGL(k_gemm<EPI_Z>, dim3(NIN / 128, T_REAL / 128), dim3(256), 0, stream, p);
      p.A = meta; p.M = NMETA; p.crow0 = T_REAL;
      hipLaunchKernelGGL(k_gemm<EPI_Z>, dim3(NIN / 128, 1), dim3(256), 0, stream, p); }
    hipLaunchKernelGGL(k_rope, dim3((MROWS + 3) / 4), dim3(256), 0, stream, Z);
    hipLaunchKernelGGL(k_s5_pw, dim3(16), dim3(64), 0, stream, lre, lim, ldt, bre, bim, pw, bb);
    hipLaunchKernelGGL(k_s5_tables, dim3(16 * 64), dim3(256), 0, stream, cre, cim, dsk, pw, bb, Kd, CL, BL);
    hipLaunchKernelGGL(k_s5_loc, dim3(65, 16), dim3(512), 0, stream, Z, BL, loc, locmeta);
    hipLaunchKernelGGL(k_s5_scan, dim3(8 * 16), dim3(64), 0, stream, loc, locmeta, pw, X);
    hipLaunchKernelGGL(k_s5_out, dim3(8 * 64, 16), dim3(1024), (64 * 256 + 64 * 16 + 128) * 4, stream, Z, Kd, CL, X, Y);
    { GemmP p{}; p.A = Y; p.lda = 256; p.B = w_glu; p.ldb = 256; p.M = T_REAL; p.N = 256; p.K = 256; p.ascale = nullptr; p.rowscale = nullptr; p.C = mixed; p.ldc = DM; p.crow0 = 0; p.aux = Y; p.ldaux = 256;
      hipLaunchKernelGGL(k_gemm<EPI_GLU>, dim3(2, T_REAL / 128), dim3(256), 0, stream, p); }
    hipLaunchKernelGGL(k_ret_kvloc, dim3(774), dim3(256), 0, stream, Z, KV);
    hipLaunchKernelGGL(k_ret_scan, dim3(48 * 64), dim3(256), 0, stream, KV);
    hipLaunchKernelGGL(k_ret_out, dim3(48 * 64), dim3(256), (64 * 129 * 2 + 64 * 128 + 64 * 65) * 4, stream, Z, KV, mixed);
    { GemmP p{}; p.A = mixed; p.lda = DM; p.B = w_out; p.ldb = DM; p.M = T_REAL; p.N = DM; p.K = DM; p.ascale = nullptr; p.rowscale = nullptr; p.C = out; p.ldc = DM; p.crow0 = 0; p.aux = x; p.ldaux = DM;
      hipLaunchKernelGGL(k_gemm<EPI_H1>, dim3(DM / 128, T_REAL / 128), dim3(256), 0, stream, p); }
    hipLaunchKernelGGL(k_router, dim3(T_REAL / 4), dim3(256), 0, stream, out, gffn, wrg, brg, wre, bre2, route, rstd2);
    hipLaunchKernelGGL(k_moe_h, dim3(T_REAL * 2), dim3(256), 0, stream, out, gffn, rstd2, route, wgate, wup, H);
    hipLaunchKernelGGL(k_moe_down, dim3(T_REAL), dim3(256), 0, stream, out, H, route, wdown, gfin);
}
```

```cpp
#include <hip/hip_runtime.h>
#include <stdint.h>
#include <cstdio>

#define T_REAL 32768
#define SEQ 4096
#define NBATCH 8
#define DM 1024
#define NIN 3328
#define NMETA 16
#define MROWS (T_REAL + NMETA)
#define EPS 1e-6f
#define ZU 0
#define ZQ 256
#define ZK 1024
#define ZV 1792
#define ZG 2560

__constant__ double c_invfreq[64] = {1.0, 0.8659643233600653, 0.7498942093324559, 0.6493816315762113, 0.5623413251903491, 0.4869675251658631, 0.4216965034285822, 0.3651741272548377, 0.31622776601683794, 0.27384196342643613, 0.23713737056616552, 0.2053525026457146, 0.1778279410038923, 0.1539926526059492, 0.1333521432163324, 0.11547819846894582, 0.1, 0.08659643233600653, 0.07498942093324558, 0.06493816315762113, 0.05623413251903491, 0.04869675251658631, 0.042169650342858224, 0.03651741272548377, 0.03162277660168379, 0.027384196342643614, 0.023713737056616554, 0.02053525026457146, 0.01778279410038923, 0.01539926526059492, 0.01333521432163324, 0.011547819846894581, 0.01, 0.008659643233600654, 0.007498942093324558, 0.006493816315762113, 0.005623413251903491, 0.004869675251658631, 0.004216965034285823, 0.003651741272548377, 0.0031622776601683794, 0.0027384196342643613, 0.0023713737056616554, 0.002053525026457146, 0.0017782794100389228, 0.001539926526059492, 0.001333521432163324, 0.0011547819846894581, 0.001, 0.0008659643233600654, 0.0007498942093324559, 0.0006493816315762113, 0.0005623413251903491, 0.0004869675251658631, 0.00042169650342858224, 0.0003651741272548377, 0.00031622776601683794, 0.0002738419634264361, 0.00023713737056616554, 0.0002053525026457146, 0.00017782794100389227, 0.0001539926526059492, 0.0001333521432163324, 0.00011547819846894582};

namespace pg8 {
#define PG8_LAS __attribute__((address_space(3)))
typedef unsigned short bf16_t;
typedef short bf16x8 __attribute__((ext_vector_type(8)));
typedef float f32x4 __attribute__((ext_vector_type(4)));
typedef unsigned u32x4 __attribute__((ext_vector_type(4)));
constexpr int BM = 256, BK = 64, HALF = 128, HTB = HALF * BK * 2  , STAGE_BYTES = 8 * HTB, NXCD = 8, WGM = 8;

__host__ __device__ __forceinline__ int lds_byte(int r, int c) { const int st = (r >> 4) * 2 + (c >> 5), rr = r & 15, cc = c & 31, ob = rr * 64 + cc * 2; return st * 1024 + (ob ^ (((ob >> 9) & 1) << 5)); }
__host__ __device__ __forceinline__ void stage_rc(int b, int& R, int& C) { const int st = b / 1024, sb = b % 1024, swz = sb ^ (((sb >> 9) & 1) << 5); R = (st >> 1) * 16 + swz / 64; C = (st & 1) * 32 + (swz % 64) / 2; }
__host__ __device__ __forceinline__ int perm32(int rho) { const int n = rho >> 4, i = rho & 15; return 8 * (i >> 2) + 4 * n + (i & 3); }

struct Unit { int pm, pn, aux0, aux1; const char* A; const char* B; };
struct Gemm { int K, lda, ldb; };

struct StaticOrder {
    int nM, nN, nwg, G, c; const char* A0; const char* B0; size_t strideA, strideB;
    __host__ __device__ void init(int M, int N, int G_, int c_) { nM = M / BM; nN = N / BM; nwg = nM * nN; G = G_; c = c_; }
    __host__ __device__ bool next(int i, Unit& u) const {
        const long L = (long)i * G + c; if (L >= nwg) return false;
        int wgid = (int)L; { const int q = nwg / NXCD, r = nwg % NXCD, xcd = wgid % NXCD, off = wgid / NXCD; wgid = (xcd < r ? xcd * (q + 1) : r * (q + 1) + (xcd - r) * q) + off; }
        const int nig = WGM * nN, gid = wgid / nig, fm = gid * WGM, gsz = (nM - fm) < WGM ? (nM - fm) : WGM;
        u.pm = fm + ((wgid % nig) % gsz); u.pn = (wgid % nig) / gsz; u.A = A0 + (size_t)u.pm * strideA; u.B = B0 + (size_t)u.pn * strideB; return true;
    }
    __device__ __forceinline__ void a_ready(const Unit&) const {}
    __device__ __forceinline__ void done(const Unit&) const {}
};

__device__ __forceinline__ unsigned cvt_pk_bf16(float lo, float hi) { unsigned r; asm volatile("v_cvt_pk_bf16_f32 %0, %1, %2" : "=v"(r) : "v"(lo), "v"(hi)); return r; }
typedef float f32x2 __attribute__((ext_vector_type(2)));
__device__ __forceinline__ f32x2 gelu_pk(f32x2 v) {
    const f32x2 av = __builtin_elementwise_abs(v), d = av * 0.2316418882f + 1.0f;
    f32x2 t; t.x = __builtin_amdgcn_rcpf(d.x); t.y = __builtin_amdgcn_rcpf(d.y);
    f32x2 q = t * 0.5307027145f + (-0.7265760135f); q = q * t + 0.7107068705f; q = q * t + (-0.142248368f); q = q * t + 0.127414796f; q = q * t;
    const f32x2 s = (v * v) * (-0.72134752044f);
    f32x2 e; e.x = __builtin_amdgcn_exp2f(s.x); e.y = __builtin_amdgcn_exp2f(s.y);
    const f32x2 m = v * (q * e), r = v - m;
    f32x2 o; o.x = v.x < 0.f ? m.x : r.x; o.y = v.y < 0.f ? m.y : r.y; return o;
}

template <int ACT  > struct EpiBf16 {
    static constexpr bool PERM = true, AFTER_DRAIN = false; static_assert(ACT == 0 || ACT == 1, "EpiBf16: ACT is 0 (none) or 1 (gelu_pk)");
    bf16_t* O; int ldc; const float* bias; int split_cols; size_t split_stride; float scale0;
    __device__ __forceinline__ void operator()(const f32x4 (&acc)[2][2][4][2], const Unit& u, int wr, int wc, int fr, int fq) const {
        const int row0 = u.pm * BM + wr * 64 + fr; int colt = u.pn * BM; bf16_t* base = O;
        float sc = 1.f; if (split_cols) { const int t = colt / split_cols; base += (size_t)t * split_stride; colt -= t * split_cols; if (t == 0) sc = scale0; }
        const int col0 = colt + wc * 32 + 8 * fq, bcol0 = u.pn * BM + wc * 32 + 8 * fq;
        f32x4 bv[2][2];
#pragma unroll
        for (int bj = 0; bj < 2; ++bj)
#pragma unroll
            for (int n = 0; n < 2; ++n) bv[bj][n] = bias ? *(const f32x4*)(bias + bcol0 + bj * HALF + 4 * n) : (f32x4){0.f, 0.f, 0.f, 0.f};
#pragma unroll
        for (int ai = 0; ai < 2; ++ai)
#pragma unroll
            for (int m = 0; m < 4; ++m) { bf16_t* rowp = base + (size_t)(row0 + ai * HALF + m * 16) * ldc + col0;
#pragma unroll
                for (int bj = 0; bj < 2; ++bj) { f32x4 v0 = acc[ai][bj][m][0] + bv[bj][0], v1 = acc[ai][bj][m][1] + bv[bj][1];
                    if (ACT == 1) { f32x2 a = gelu_pk((f32x2){v0[0], v0[1]}), b = gelu_pk((f32x2){v0[2], v0[3]}), c = gelu_pk((f32x2){v1[0], v1[1]}), d = gelu_pk((f32x2){v1[2], v1[3]});
                        v0 = (f32x4){a.x, a.y, b.x, b.y}; v1 = (f32x4){c.x, c.y, d.x, d.y}; }
                    v0 = v0 * sc; v1 = v1 * sc; u32x4 w; w.x = cvt_pk_bf16(v0[0], v0[1]); w.y = cvt_pk_bf16(v0[2], v0[3]); w.z = cvt_pk_bf16(v1[0], v1[1]); w.w = cvt_pk_bf16(v1[2], v1[3]);
                    *(u32x4*)(rowp + bj * HALF) = w; } }
    }
};

template <class Epi, class Sched, bool ALIGN_EPI = false, bool SP2 = false, bool GATHER = false>
__device__ __forceinline__ void gemm_phase(PG8_LAS unsigned char* lds, const Gemm g, const Sched& S, const Epi& E, const PG8_LAS int* ridx = nullptr) {
    const int tid = threadIdx.x, wid = __builtin_amdgcn_readfirstlane(tid >> 6), lane = tid & 63, wr = wid >> 2, wc = wid & 3, fr = lane & 15, fq = lane >> 4;
    const int K = g.K, nt = K / BK, lda = g.lda, ldb = g.ldb;
    unsigned vA0[2], vA1[2], voffB[2];
#pragma unroll
    for (int i = 0; i < 2; ++i) { int R, C; stage_rc(tid * 16 + i * 8192, R, C); const int Rb = Epi::PERM ? ((R & ~31) + perm32(R & 31)) : R;
        vA0[i] = (unsigned)(R * lda + C) * 2u; vA1[i] = (unsigned)((R + HALF) * lda + C) * 2u; voffB[i] = (unsigned)(Rb * ldb + C) * 2u; }
#define PG8_GOFF(slot, d0, d1) do { _Pragma("unroll") for (int _i = 0; _i < 2; ++_i) { int _R, _C; stage_rc(tid * 16 + _i * 8192, _R, _C); \
        d0[_i] = (unsigned)ridx[(slot) * 256 + _R] * (unsigned)(lda * 2) + (unsigned)(_C * 2); d1[_i] = (unsigned)ridx[(slot) * 256 + HALF + _R] * (unsigned)(lda * 2) + (unsigned)(_C * 2); } } while (0)
    if constexpr (GATHER) { PG8_GOFF(0, vA0, vA1); }
    const size_t kstep = (size_t)(BK * 2);
    const size_t hstepB = (size_t)HALF * ldb * 2;
    const unsigned ldsw = (unsigned)wid * 1024u;
    const int aoff = lds_byte(wr * 64 + fr, fq * 8), boff = lds_byte(wc * 32 + fr, fq * 8);
#define PG8_SA(b, h) (((b) * 2 + (h)) * HTB)
#define PG8_SB(b, h) ((4 + (b) * 2 + (h)) * HTB)
#define PG8_STAGE(bufoff, gbase, voff) do { _Pragma("unroll") for (int _i = 0; _i < 2; ++_i) \
        __builtin_amdgcn_global_load_lds((const unsigned*)((const char*)(gbase) + (voff)[_i]), (PG8_LAS unsigned*)(lds + (bufoff) + ldsw + _i * 8192), 16, 0, 0); } while (0)
#define PG8_LDA(dst, b, h) do { _Pragma("unroll") for (int m = 0; m < 4; ++m) _Pragma("unroll") for (int k = 0; k < 2; ++k) dst[m][k] = *(const PG8_LAS bf16x8*)(lds + PG8_SA(b, h) + aoff + m * 2048 + k * 1024); } while (0)
#define PG8_LDB(dst, b, h) do { _Pragma("unroll") for (int n = 0; n < 2; ++n) _Pragma("unroll") for (int k = 0; k < 2; ++k) dst[n][k] = *(const PG8_LAS bf16x8*)(lds + PG8_SB(b, h) + boff + n * 2048 + k * 1024); } while (0)
#define PG8_MMA(ai, bj, At, Bt) do { __builtin_amdgcn_s_setprio(1); _Pragma("unroll") for (int m = 0; m < 4; ++m) _Pragma("unroll") for (int n = 0; n < 2; ++n) _Pragma("unroll") for (int k = 0; k < 2; ++k) \
        acc[ai][bj][m][n] = __builtin_amdgcn_mfma_f32_16x16x32_bf16(Bt[n][k], At[m][k], acc[ai][bj][m][n], 0, 0, 0); __builtin_amdgcn_s_setprio(0); } while (0)
#define PG8_WAIT_V(n) asm volatile("s_waitcnt vmcnt(" #n ")" ::: "memory")
#define PG8_WAIT_L(n) asm volatile("s_waitcnt lgkmcnt(" #n ")" ::: "memory")
#define PG8_BAR __builtin_amdgcn_s_barrier()
#define PG8_SCHED __builtin_amdgcn_sched_barrier(0)
    Unit cur, nxt; int ui = 0;
    if (!S.next(0, cur)) return;
    f32x4 acc[2][2][4][2];
#pragma unroll
    for (int a = 0; a < 2; ++a)
#pragma unroll
        for (int b = 0; b < 2; ++b)
#pragma unroll
            for (int m = 0; m < 4; ++m)
#pragma unroll
                for (int n = 0; n < 2; ++n) acc[a][b][m][n] = (f32x4){0.f, 0.f, 0.f, 0.f};
    bf16x8 At[4][2], B0[2][2], B1[2][2];
    const char* cA = cur.A; const char* cB = cur.B;
    S.a_ready(cur);
    if constexpr (SP2) {
        PG8_STAGE(PG8_SB(0, 0), cB, voffB); PG8_STAGE(PG8_SB(0, 1), cB + hstepB, voffB); PG8_STAGE(PG8_SA(0, 0), cA, vA0); PG8_STAGE(PG8_SA(0, 1), cA, vA1);
        if (wr == 1) PG8_BAR;
        PG8_WAIT_V(2); PG8_BAR;
        PG8_STAGE(PG8_SB(1, 0), cB + kstep, voffB); PG8_STAGE(PG8_SA(1, 0), cA + kstep, vA0); PG8_STAGE(PG8_SB(1, 1), cB + hstepB + kstep, voffB);
        PG8_WAIT_V(6); PG8_BAR;
    } else {
        PG8_STAGE(PG8_SB(0, 0), cB, voffB); PG8_STAGE(PG8_SA(0, 0), cA, vA0); PG8_STAGE(PG8_SB(0, 1), cB + hstepB, voffB); PG8_STAGE(PG8_SA(0, 1), cA, vA1);
        if (wr == 1) PG8_BAR;
        PG8_WAIT_V(4); PG8_BAR;
        PG8_STAGE(PG8_SB(1, 0), cB + kstep, voffB); PG8_STAGE(PG8_SA(1, 0), cA + kstep, vA0); PG8_STAGE(PG8_SB(1, 1), cB + hstepB + kstep, voffB);
        PG8_WAIT_V(6); PG8_BAR;
    }
    for (;;) {
        const bool has_next = S.next(ui + 1, nxt);
        const char* nA = has_next ? nxt.A : cA; const char* nB = has_next ? nxt.B : cB;
#pragma unroll 1
        for (int t = 0; t < nt; t += 2) {
            const bool last = (t == nt - 2);
            const char* a1 = cA + (size_t)(t + 1) * kstep;
            const char* a2 = last ? nA : cA + (size_t)(t + 2) * kstep; const char* b2 = last ? nB : cB + (size_t)(t + 2) * kstep;
            const char* a3 = a2 + kstep; const char* b3 = b2 + kstep;
            if (last && has_next) S.a_ready(nxt);
            unsigned sA0[2], sA1[2];
#pragma unroll
            for (int _i = 0; _i < 2; ++_i) { sA0[_i] = vA0[_i]; sA1[_i] = vA1[_i]; }
            if constexpr (GATHER) { if (last && has_next) { PG8_GOFF(ui + 1, sA0, sA1); } }
            if constexpr (SP2) {
            PG8_LDB(B0, 0, 0); PG8_LDB(B1, 0, 1); PG8_SCHED; PG8_LDA(At, 0, 0); PG8_STAGE(PG8_SA(1, 1), a1, vA1);
            PG8_WAIT_V(8); PG8_WAIT_L(0); PG8_BAR; PG8_MMA(0, 0, At, B0); PG8_MMA(0, 1, At, B1); PG8_BAR; PG8_SCHED;
            PG8_LDA(At, 0, 1); PG8_STAGE(PG8_SB(0, 0), b2, voffB); PG8_STAGE(PG8_SB(0, 1), b2 + hstepB, voffB); PG8_STAGE(PG8_SA(0, 0), a2, sA0);
            PG8_WAIT_V(8); PG8_WAIT_L(0); PG8_BAR; PG8_MMA(1, 0, At, B0); PG8_MMA(1, 1, At, B1); PG8_BAR; PG8_SCHED;
            PG8_LDB(B0, 1, 0); PG8_LDB(B1, 1, 1); PG8_SCHED; PG8_LDA(At, 1, 0); PG8_STAGE(PG8_SA(0, 1), a2, sA1);
            PG8_WAIT_V(8); PG8_WAIT_L(0); PG8_BAR; PG8_MMA(0, 0, At, B0); PG8_MMA(0, 1, At, B1); PG8_BAR; PG8_SCHED;
            PG8_LDA(At, 1, 1); PG8_STAGE(PG8_SB(1, 0), b3, voffB); PG8_STAGE(PG8_SB(1, 1), b3 + hstepB, voffB); PG8_STAGE(PG8_SA(1, 0), a3, sA0);
            PG8_WAIT_V(8); PG8_WAIT_L(0); PG8_BAR; PG8_MMA(1, 0, At, B0); PG8_MMA(1, 1, At, B1); PG8_BAR; PG8_SCHED;
            } else {
            PG8_LDB(B0, 0, 0); PG8_SCHED; PG8_LDA(At, 0, 0); PG8_STAGE(PG8_SA(1, 1), a1, vA1);
            PG8_WAIT_L(8); PG8_BAR; PG8_WAIT_L(0); PG8_MMA(0, 0, At, B0); PG8_BAR; PG8_SCHED;
            PG8_LDB(B1, 0, 1); PG8_STAGE(PG8_SB(0, 0), b2, voffB);
            PG8_BAR; PG8_WAIT_L(0); PG8_MMA(0, 1, At, B1); PG8_BAR;
            PG8_LDA(At, 0, 1); PG8_STAGE(PG8_SA(0, 0), a2, sA0);
            PG8_BAR; PG8_WAIT_L(0); PG8_MMA(1, 0, At, B0); PG8_BAR; PG8_SCHED;
            PG8_STAGE(PG8_SB(0, 1), b2 + hstepB, voffB);
            PG8_WAIT_V(6); PG8_BAR; PG8_MMA(1, 1, At, B1); PG8_BAR;
            PG8_LDB(B0, 1, 0); PG8_SCHED; PG8_LDA(At, 1, 0); PG8_STAGE(PG8_SA(0, 1), a2, sA1);
            PG8_WAIT_L(8); PG8_BAR; PG8_WAIT_L(0); PG8_MMA(0, 0, At, B0); PG8_BAR; PG8_SCHED;
            PG8_LDB(B1, 1, 1); PG8_STAGE(PG8_SB(1, 0), b3, voffB);
            PG8_BAR; PG8_WAIT_L(0); PG8_MMA(0, 1, At, B1); PG8_BAR;
            PG8_LDA(At, 1, 1); PG8_STAGE(PG8_SA(1, 0), a3, sA0);
            PG8_BAR; PG8_WAIT_L(0); PG8_MMA(1, 0, At, B0); PG8_BAR; PG8_SCHED;
            PG8_STAGE(PG8_SB(1, 1), b3 + hstepB, voffB);
            PG8_WAIT_V(6); PG8_BAR; PG8_MMA(1, 1, At, B1); PG8_BAR;
            }
        }
        if constexpr (ALIGN_EPI) { if (wr == 0) PG8_BAR; }
        if constexpr (!Epi::AFTER_DRAIN) { E(acc, cur, wr, wc, fr, fq); S.done(cur); }
        if (!has_next) break;
#pragma unroll
        for (int a = 0; a < 2; ++a)
#pragma unroll
            for (int b = 0; b < 2; ++b)
#pragma unroll
                for (int m = 0; m < 4; ++m)
#pragma unroll
                    for (int n = 0; n < 2; ++n) acc[a][b][m][n] = (f32x4){0.f, 0.f, 0.f, 0.f};
        cur = nxt; cA = nA; cB = nB; ++ui;
        if constexpr (GATHER) { PG8_GOFF(ui, vA0, vA1); }
        if constexpr (ALIGN_EPI) { if (wr == 1) PG8_BAR; }
    }
    PG8_WAIT_V(0);
    if constexpr (!ALIGN_EPI) { if (wr == 0) PG8_BAR; }
    PG8_BAR;
    if constexpr (Epi::AFTER_DRAIN) { E.fused(acc, cur, wr, wc, fr, fq, lds, wid, lane); S.done(cur); }
#undef PG8_GOFF
#undef PG8_SA
#undef PG8_SB
#undef PG8_STAGE
#undef PG8_LDA
#undef PG8_LDB
#undef PG8_MMA
#undef PG8_WAIT_V
#undef PG8_WAIT_L
#undef PG8_BAR
#undef PG8_SCHED
}
}

namespace pg8 {
struct EpiResF32 {
    static constexpr bool PERM = false, AFTER_DRAIN = false;
    const float* base; float* C; int ldc;
    __device__ __forceinline__ void operator()(const f32x4 (&acc)[2][2][4][2], const Unit& u, int wr, int wc, int fr, int fq) const {
        const int row0 = u.pm * BM + wr * 64 + fr, col0 = u.pn * BM + wc * 32 + 4 * fq;
#pragma unroll
        for (int ai = 0; ai < 2; ++ai)
#pragma unroll
            for (int m = 0; m < 4; ++m) { const size_t off = (size_t)(row0 + ai * HALF + m * 16) * ldc + col0;
#pragma unroll
                for (int bj = 0; bj < 2; ++bj)
#pragma unroll
                    for (int n = 0; n < 2; ++n) { const f32x4 b = *(const f32x4*)(base + off + bj * HALF + n * 16); *(f32x4*)(C + off + bj * HALF + n * 16) = acc[ai][bj][m][n] + b; } }
    }
};
}
namespace pg8 {
struct EpiRes2 {
    static constexpr bool PERM = false, AFTER_DRAIN = false;
    const float* base; float* C; bf16_t* Cb; int ldc;
    __device__ __forceinline__ void operator()(const f32x4 (&acc)[2][2][4][2], const Unit& u, int wr, int wc, int fr, int fq) const {
        const int row0 = u.pm * BM + wr * 64 + fr, col0 = u.pn * BM + wc * 32 + 4 * fq;
#pragma unroll
        for (int ai = 0; ai < 2; ++ai)
#pragma unroll
            for (int m = 0; m < 4; ++m) { const size_t off = (size_t)(row0 + ai * HALF + m * 16) * ldc + col0;
#pragma unroll
                for (int bj = 0; bj < 2; ++bj)
#pragma unroll
                    for (int n = 0; n < 2; ++n) { const f32x4 b = *(const f32x4*)(base + off + bj * HALF + n * 16); const f32x4 v = acc[ai][bj][m][n] + b; *(f32x4*)(C + off + bj * HALF + n * 16) = v;
                        typedef unsigned u32x2 __attribute__((ext_vector_type(2))); u32x2 w; w.x = cvt_pk_bf16(v[0], v[1]); w.y = cvt_pk_bf16(v[2], v[3]); *(u32x2*)(Cb + off + bj * HALF + n * 16) = w; } }
    }
};
struct EpiMoeH {
    static constexpr bool PERM = false, AFTER_DRAIN = false;
    bf16_t* H; const float* wlo; const float* whi; const float* rs;
    __device__ __forceinline__ void operator()(const f32x4 (&acc)[2][2][4][2], const Unit& u, int wr, int wc, int fr, int fq) const {
        const float* wsel = (u.pn >> 1) ? whi : wlo; const size_t pbase = (size_t)u.aux0 * 32768 + u.aux1;
        typedef unsigned u32x2 __attribute__((ext_vector_type(2)));
#pragma unroll
        for (int ai = 0; ai < 2; ++ai)
#pragma unroll
            for (int m = 0; m < 4; ++m) { const int r = ai * HALF + wr * 64 + m * 16 + fr; const float rsv = rs[pbase + r], wv = wsel[pbase + r];
#pragma unroll
                for (int bj = 0; bj < 2; ++bj) { const f32x4 g = acc[ai][bj][m][0] * rsv, up = acc[ai][bj][m][1] * rsv; float h[4];
#pragma unroll
                    for (int j = 0; j < 4; ++j) h[j] = g[j] / (1.f + __expf(-g[j])) * up[j] * wv;
                    const int f = (((u.pn & 1) * 8 + 4 * bj + wc) * 16) + 4 * fq;
                    u32x2 w; w.x = cvt_pk_bf16(h[0], h[1]); w.y = cvt_pk_bf16(h[2], h[3]);
                    *(u32x2*)(H + (size_t)(u.pm * BM + r) * 512 + (u.pn >> 1) * 256 + f) = w; } }
    }
};
struct EpiMoeDown {
    static constexpr bool PERM = false, AFTER_DRAIN = false;
    float* out; const int* idx; const PG8_LAS int* tab;
    __device__ __forceinline__ void operator()(const f32x4 (&acc)[2][2][4][2], const Unit& u, int wr, int wc, int fr, int fq) const {
        const int cnt = tab[u.aux0]; const size_t pbase = (size_t)u.aux0 * 32768; const int col0 = u.pn * BM + wc * 32 + 4 * fq;
#pragma unroll
        for (int ai = 0; ai < 2; ++ai)
#pragma unroll
            for (int m = 0; m < 4; ++m) { const int pos = u.aux1 + ai * HALF + wr * 64 + m * 16 + fr;
                if (pos < cnt) { const int tok = idx[pbase + pos]; float* o = out + (size_t)tok * 1024 + col0;
#pragma unroll
                    for (int bj = 0; bj < 2; ++bj)
#pragma unroll
                        for (int n = 0; n < 2; ++n) { f32x4* p = (f32x4*)(o + bj * HALF + n * 16); *p = *p + acc[ai][bj][m][n]; } } }
    }
};
struct MoeOrder {
    const PG8_LAS int* utab; int down; const char* A0; const char* B0;
    __device__ __forceinline__ bool next(int i, Unit& u) const {
        if (i >= 8) return false;
        const int t = __builtin_amdgcn_readfirstlane(utab[i * 4]); if (t < 0) return false;
        const int pn = __builtin_amdgcn_readfirstlane(utab[i * 4 + 1]), cls = __builtin_amdgcn_readfirstlane(utab[i * 4 + 2]), pos0 = __builtin_amdgcn_readfirstlane(utab[i * 4 + 3]);
        u.pm = t; u.pn = pn; u.aux0 = cls; u.aux1 = pos0;
        const int gi = cls / 6, p = cls - gi * 6; const int ea = p < 3 ? 0 : (p < 5 ? 1 : 2), eb = p < 3 ? p + 1 : (p < 5 ? p - 1 : 3);
        if (down) { u.A = A0 + (size_t)t * 256 * 512 * 2; u.B = B0 + ((size_t)cls * 1024 + pn * 256) * 512 * 2; }
        else { const int e = gi * 4 + ((pn >> 1) ? eb : ea); u.A = A0; u.B = B0 + ((size_t)e * 512 + (pn & 1) * 256) * 1024 * 2; }
        return true;
    }
    __device__ __forceinline__ void a_ready(const Unit&) const {}
    __device__ __forceinline__ void done(const Unit&) const {}
};
}
#ifndef PG8_SP2
#define PG8_SP2 true
#endif
#ifndef PG8_ALIGN
#define PG8_ALIGN true
#endif

#define GAS __attribute__((address_space(1)))
#define LAS __attribute__((address_space(3)))
typedef unsigned short bf16;
typedef unsigned short bf16_t;
typedef unsigned v4u __attribute__((ext_vector_type(4)));
typedef float f32x4 __attribute__((ext_vector_type(4)));
typedef GAS unsigned gu32;
#define RLX_AGENT __ATOMIC_RELAXED, __HIP_MEMORY_SCOPE_AGENT
#define LDS_WAIT() asm volatile("s_waitcnt lgkmcnt(0)" ::: "memory")
#define VM_WAIT() asm volatile("s_waitcnt vmcnt(0)" ::: "memory")
__device__ __forceinline__ unsigned f2bf_u(float f) { unsigned u = __builtin_bit_cast(unsigned, f); return (u + 0x7fffu + ((u >> 16) & 1u)) >> 16; }
__device__ __forceinline__ unsigned pk2(float lo, float hi) { return f2bf_u(lo) | (f2bf_u(hi) << 16); }
__device__ __forceinline__ float bf2f(bf16_t b) { return __uint_as_float(((unsigned)b) << 16); }
__device__ __forceinline__ bf16_t f2bf(float f) { return (bf16_t)f2bf_u(f); }

#define XB_TMO      128
#define XB_XCNT(j)  (256  + 64 * (j))
#define XB_XSUB(j)  (1280 + 64 * (j))
#define XB_XGEN(j)  (2304 + 64 * (j))
#define XB_TOP      3328
#define XB_TOPGEN   3392
#define XCD_BAR_WORDS 3456
#define XB_SPIN_CAP (1u << 18)

__device__ __forceinline__ unsigned xb_ld(unsigned* p)              { return __hip_atomic_load(p, __ATOMIC_RELAXED, __HIP_MEMORY_SCOPE_AGENT); }
__device__ __forceinline__ unsigned xb_add(unsigned* p, unsigned v) { return __hip_atomic_fetch_add(p, v, __ATOMIC_RELAXED, __HIP_MEMORY_SCOPE_AGENT); }
__device__ __forceinline__ unsigned xb_xcc_id() { return (unsigned)__builtin_amdgcn_s_getreg((3 << 11) | 20) & 0xFu; }
#define XB_SPIN(cond, bar) do { unsigned _sp = 0; while (cond) { __builtin_amdgcn_s_sleep(1); \
    if ((++_sp & 255u) == 0u) { if (xb_ld(&(bar)[XB_TMO])) break; if (_sp > XB_SPIN_CAP) { atomicAdd(&(bar)[XB_TMO], 1u); break; } } } } while (0)

struct XcdBarrier {
    unsigned* bar; unsigned x;
    volatile LAS unsigned* st;
};

__device__ __forceinline__ XcdBarrier xcd_barrier_post(unsigned* bar, volatile LAS unsigned* st) {
    XcdBarrier b; b.bar = bar; b.x = xb_xcc_id(); b.st = st;
    if (threadIdx.x == 0) (void)xb_add(&bar[XB_XCNT(b.x)], 1u);
    return b;
}
__device__ __forceinline__ void xcd_barrier_complete(unsigned* bar, unsigned x, unsigned& nloc, unsigned& nx) {
    const unsigned G = gridDim.x * gridDim.y * gridDim.z;
    unsigned sum, cnt, mine, sp = 0u;
    for (;;) {
        sum = 0u; cnt = 0u; mine = 0u;
#pragma unroll
        for (unsigned j = 0; j < 16; ++j) { const unsigned c = xb_ld(&bar[XB_XCNT(j)]); sum += c; cnt += (c > 0u) ? 1u : 0u; mine = (j == x) ? c : mine; }
        if (sum == G) break;
        __builtin_amdgcn_s_sleep(1);
        if ((++sp & 255u) == 0u) { if (xb_ld(&bar[XB_TMO])) break; if (sp > XB_SPIN_CAP) { atomicAdd(&bar[XB_TMO], 1u); break; } }
    }
    nloc = mine > 0u ? mine : 1u; nx = cnt > 0u ? cnt : 1u;
}

__device__ __forceinline__ void xcd_barrier(const XcdBarrier& b) {
    asm volatile("s_waitcnt vmcnt(0)" ::: "memory");
    __syncthreads();
    if (threadIdx.x == 0) {
        unsigned* bar = b.bar;
        __builtin_amdgcn_s_waitcnt(0);
        unsigned nloc = b.st[0], nx = b.st[1];
        if (nloc == 0u) { xcd_barrier_complete(bar, b.x, nloc, nx); b.st[0] = nloc; b.st[1] = nx; }
        const unsigned old = xb_add(&bar[XB_XSUB(b.x)], 1u);
        const unsigned gen = old / nloc;
        if (old + 1u == (gen + 1u) * nloc) {
            __builtin_amdgcn_fence(__ATOMIC_RELEASE, "agent");
            asm volatile("s_waitcnt vmcnt(0)" ::: "memory");
            const unsigned og = xb_add(&bar[XB_TOP], 1u);
            const unsigned tg = og / nx;
            if (og + 1u == (tg + 1u) * nx) xb_add(&bar[XB_TOPGEN], 1u);
            else XB_SPIN(xb_ld(&bar[XB_TOPGEN]) == tg, bar);
            __builtin_amdgcn_fence(__ATOMIC_ACQUIRE, "agent");
            xb_add(&bar[XB_XGEN(b.x)], 1u);
            asm volatile("s_waitcnt vmcnt(0)" ::: "memory");
        } else {
            XB_SPIN(xb_ld(&bar[XB_XGEN(b.x)]) == gen, bar);
            __builtin_amdgcn_fence(__ATOMIC_ACQUIRE, "agent");
            asm volatile("s_waitcnt vmcnt(0)" ::: "memory");
        }
    }
    __syncthreads();
}

namespace pg8 {
struct S5Order {
    int G, c; const char* A0; const char* B0; size_t strideAg, strideBg;
    __device__ __forceinline__ bool next(int i, Unit& u) const {
        const int L = i * G + c; if (L >= 128) return false;
        const int g = L >> 3, rt = L & 7; u.pm = L; u.pn = 0; u.aux0 = g; u.aux1 = rt;
        u.A = A0 + (size_t)g * strideAg + (size_t)rt * 256 * 384 * 2; u.B = B0 + (size_t)g * strideBg; return true;
    }
    __device__ __forceinline__ void a_ready(const Unit&) const {}
    __device__ __forceinline__ void done(const Unit&) const {}
};
struct EpiS5Loc {
    static constexpr bool PERM = false, AFTER_DRAIN = false;
    float* loc;
    __device__ __forceinline__ void operator()(const f32x4 (&acc)[2][2][4][2], const Unit& u, int wr, int wc, int fr, int fq) const {
        float* base = loc + ((size_t)u.aux0 * 2048 + u.aux1 * 256) * 128; const int col0 = wc * 32 + 4 * fq;
#pragma unroll
        for (int ai = 0; ai < 2; ++ai)
#pragma unroll
            for (int m = 0; m < 4; ++m) { float* rowp = base + (size_t)(ai * HALF + wr * 64 + m * 16 + fr) * 128 + col0;
#pragma unroll
                for (int n = 0; n < 2; ++n) *(f32x4*)(rowp + n * 16) = acc[ai][0][m][n]; }
    }
};
__device__ __forceinline__ float gelu_tanh_f(float x) { const float z = 1.5957691216057308f * (x + 0.044715f * x * x * x); return x - x * __builtin_amdgcn_rcpf(1.f + __expf(z)); }
struct EpiS5Y {
    static constexpr bool PERM = true, AFTER_DRAIN = false;
    bf16_t* Y;
    __device__ __forceinline__ void operator()(const f32x4 (&acc)[2][2][4][2], const Unit& u, int wr, int wc, int fr, int fq) const {
        const int g = u.aux0, rt = u.aux1;
#pragma unroll
        for (int ai = 0; ai < 2; ++ai)
#pragma unroll
            for (int m = 0; m < 4; ++m) { const int r = rt * 256 + ai * HALF + wr * 64 + m * 16 + fr; const size_t tok0 = (size_t)(r >> 8) * 4096 + (size_t)(r & 255) * 16;
#pragma unroll
                for (int bj = 0; bj < 2; ++bj) { const int n0 = bj * HALF + wc * 32 + 8 * fq; const f32x4 v0 = acc[ai][bj][m][0], v1 = acc[ai][bj][m][1];
                    u32x4 w; w.x = cvt_pk_bf16(gelu_tanh_f(v0[0]), gelu_tanh_f(v0[1])); w.y = cvt_pk_bf16(gelu_tanh_f(v0[2]), gelu_tanh_f(v0[3])); w.z = cvt_pk_bf16(gelu_tanh_f(v1[0]), gelu_tanh_f(v1[1])); w.w = cvt_pk_bf16(gelu_tanh_f(v1[2]), gelu_tanh_f(v1[3]));
                    *(u32x4*)(Y + (tok0 + (n0 >> 4)) * 256 + g * 16 + (n0 & 15)) = w; } }
    }
};
struct EpiGlu {
    static constexpr bool PERM = true, AFTER_DRAIN = false;
    const bf16_t* Y; bf16_t* O; int ldo;
    __device__ __forceinline__ void operator()(const f32x4 (&acc)[2][2][4][2], const Unit& u, int wr, int wc, int fr, int fq) const {
        const int row0 = u.pm * BM + wr * 64 + fr, col0 = wc * 32 + 8 * fq;
#pragma unroll
        for (int ai = 0; ai < 2; ++ai)
#pragma unroll
            for (int m = 0; m < 4; ++m) { const size_t row = (size_t)(row0 + ai * HALF + m * 16);
#pragma unroll
                for (int bj = 0; bj < 2; ++bj) { const u32x4 yv = *(const u32x4*)(Y + row * 256 + col0 + bj * HALF); const f32x4 v0 = acc[ai][bj][m][0], v1 = acc[ai][bj][m][1]; float o[8];
#pragma unroll
                    for (int q = 0; q < 4; ++q) { const float ylo = __uint_as_float(yv[q] << 16), yhi = __uint_as_float(yv[q] & 0xffff0000u); const float a0 = q < 2 ? v0[2 * q] : v1[2 * q - 4], a1 = q < 2 ? v0[2 * q + 1] : v1[2 * q - 3];
                        o[2 * q] = ylo * __builtin_amdgcn_rcpf(1.f + __expf(-a0)); o[2 * q + 1] = yhi * __builtin_amdgcn_rcpf(1.f + __expf(-a1)); }
                    u32x4 w; w.x = cvt_pk_bf16(o[0], o[1]); w.y = cvt_pk_bf16(o[2], o[3]); w.z = cvt_pk_bf16(o[4], o[5]); w.w = cvt_pk_bf16(o[6], o[7]);
                    *(u32x4*)(O + row * ldo + col0 + bj * HALF) = w; } }
    }
};
}

namespace pg8 {
struct EpiZ {
    static constexpr bool PERM = true, AFTER_DRAIN = false;
    bf16_t* Z; int ldz; bf16_t* A2; const float* CS;
    __device__ __forceinline__ void operator()(const f32x4 (&acc)[2][2][4][2], const Unit& u, int wr, int wc, int fr, int fq) const {
        const int row0 = u.pm * BM + wr * 64 + fr;
        if (u.pn == 0) {
#pragma unroll
            for (int ai = 0; ai < 2; ++ai)
#pragma unroll
                for (int m = 0; m < 4; ++m) { const int row = row0 + ai * HALF + m * 16, b = row >> 12, sq = row & 4095;
#pragma unroll
                    for (int bj = 0; bj < 2; ++bj) { const int ch = bj * HALF + wc * 32 + 8 * fq; const f32x4 v0 = acc[ai][bj][m][0], v1 = acc[ai][bj][m][1];
                        u32x4 w; w.x = cvt_pk_bf16(v0[0], v0[1]); w.y = cvt_pk_bf16(v0[2], v0[3]); w.z = cvt_pk_bf16(v1[0], v1[1]); w.w = cvt_pk_bf16(v1[2], v1[3]);
                        *(u32x4*)(A2 + ((size_t)(ch >> 4) * 2048 + b * 256 + (sq >> 4)) * 384 + 128 + (sq & 15) * 16 + (ch & 15)) = w; } }
        } else if (u.pn <= 6) {
            const int i0 = 16 * wc + 4 * fq;
#pragma unroll
            for (int ai = 0; ai < 2; ++ai)
#pragma unroll
                for (int m = 0; m < 4; ++m) { const int row = row0 + ai * HALF + m * 16, sq = row & 4095;
                    const f32x4 c0 = *(const f32x4*)(CS + ((size_t)sq * 64 + i0) * 2), c1 = *(const f32x4*)(CS + ((size_t)sq * 64 + i0) * 2 + 4);
                    bf16_t* rowp = Z + (size_t)row * ldz + u.pn * BM + wc * 32 + 8 * fq;
#pragma unroll
                    for (int bj = 0; bj < 2; ++bj) { const f32x4 v0 = acc[ai][bj][m][0], v1 = acc[ai][bj][m][1];
                        u32x4 w; w.x = cvt_pk_bf16(v0[0] * c0[0] - v0[1] * c0[1], v0[1] * c0[0] + v0[0] * c0[1]); w.y = cvt_pk_bf16(v0[2] * c0[2] - v0[3] * c0[3], v0[3] * c0[2] + v0[2] * c0[3]);
                        w.z = cvt_pk_bf16(v1[0] * c1[0] - v1[1] * c1[1], v1[1] * c1[0] + v1[0] * c1[1]); w.w = cvt_pk_bf16(v1[2] * c1[2] - v1[3] * c1[3], v1[3] * c1[2] + v1[2] * c1[3]);
                        *(u32x4*)(rowp + bj * HALF) = w; } }
        } else {
#pragma unroll
            for (int ai = 0; ai < 2; ++ai)
#pragma unroll
                for (int m = 0; m < 4; ++m) { bf16_t* rowp = Z + (size_t)(row0 + ai * HALF + m * 16) * ldz + u.pn * BM + wc * 32 + 8 * fq;
#pragma unroll
                    for (int bj = 0; bj < 2; ++bj) { const f32x4 v0 = acc[ai][bj][m][0], v1 = acc[ai][bj][m][1];
                        u32x4 w; w.x = cvt_pk_bf16(v0[0], v0[1]); w.y = cvt_pk_bf16(v0[2], v0[3]); w.z = cvt_pk_bf16(v1[0], v1[1]); w.w = cvt_pk_bf16(v1[2], v1[3]);
                        *(u32x4*)(rowp + bj * HALF) = w; } }
        }
    }
};
}

namespace ret {
using bf16x8 = __attribute__((ext_vector_type(8))) short;
using s16x4  = __attribute__((ext_vector_type(4))) short;
using f32x16 = __attribute__((ext_vector_type(16))) float;
using u32x4  = __attribute__((ext_vector_type(4))) unsigned;
#define RET_KSWZ(row, colB) ((row) * 256 + ((colB) ^ (((row) & 7) << 4)))
#define RET_SBAR() __builtin_amdgcn_sched_barrier(0)
__device__ __forceinline__ int crow(int r, int hi) { return (r & 3) + 8 * (r >> 2) + 4 * hi; }
__device__ __forceinline__ unsigned cvtpk(float lo, float hi) { unsigned r; asm volatile("v_cvt_pk_bf16_f32 %0, %1, %2" : "=v"(r) : "v"(lo), "v"(hi)); return r; }
__device__ __forceinline__ int v_st(int k, int c) { const int kk = (k & ~0xC) | ((k & 4) << 1) | ((k & 8) >> 1); return ((kk >> 3) * 4 + (c >> 5)) * 512 + ((kk & 7) * 32 + (c & 31)) * 2; }
__device__ __forceinline__ int v_rd_base(int lane) { return ((lane & 3) << 3) | (((lane >> 2) & 3) << 6) | (((lane >> 4) & 1) << 5) | (((lane >> 5) & 1) << 8); }
constexpr int v_rd_off(int d0, int ks, int half) { return d0 * 512 + ks * 4096 + half * 2048; }
template <int OFF> __device__ __forceinline__ s16x4 tr_read(int vb) { s16x4 r; asm volatile("ds_read_b64_tr_b16 %0, %1 offset:%2" : "=&v"(r) : "v"(vb), "i"(OFF) : "memory"); return r; }
#define RET_PK(L, H) (bf16x8){L[0], L[1], L[2], L[3], H[0], H[1], H[2], H[3]}
__device__ __forceinline__ void qkt(f32x16& p0, f32x16& p1, const LAS unsigned char* Ks, const bf16x8 (&qr)[8], int r32, int hi) {
    p0 = f32x16{}; p1 = f32x16{};
#pragma unroll
    for (int d0 = 0; d0 < 8; ++d0) { const int cb = (d0 * 16 + hi * 8) * 2;
        const bf16x8 b0 = *(const LAS bf16x8*)(Ks + RET_KSWZ(r32, cb));
        const bf16x8 b1 = *(const LAS bf16x8*)(Ks + RET_KSWZ(32 + r32, cb));
        p0 = __builtin_amdgcn_mfma_f32_32x32x16_bf16(b0, qr[d0], p0, 0, 0, 0);
        p1 = __builtin_amdgcn_mfma_f32_32x32x16_bf16(b1, qr[d0], p1, 0, 0, 0); }
}
template <int D0> __device__ __forceinline__ void pv_one(f32x16& od, int vb, bf16x8 pa0, bf16x8 pa1, bf16x8 pa2, bf16x8 pa3) {
    const s16x4 l0 = tr_read<v_rd_off(D0, 0, 0)>(vb), h0 = tr_read<v_rd_off(D0, 0, 1)>(vb), l1 = tr_read<v_rd_off(D0, 1, 0)>(vb), h1 = tr_read<v_rd_off(D0, 1, 1)>(vb);
    const s16x4 l2 = tr_read<v_rd_off(D0, 2, 0)>(vb), h2 = tr_read<v_rd_off(D0, 2, 1)>(vb), l3 = tr_read<v_rd_off(D0, 3, 0)>(vb), h3 = tr_read<v_rd_off(D0, 3, 1)>(vb);
    asm volatile("s_waitcnt lgkmcnt(0)" ::: "memory"); RET_SBAR();
    od = __builtin_amdgcn_mfma_f32_32x32x16_bf16(pa0, RET_PK(l0, h0), od, 0, 0, 0);
    od = __builtin_amdgcn_mfma_f32_32x32x16_bf16(pa1, RET_PK(l1, h1), od, 0, 0, 0);
    od = __builtin_amdgcn_mfma_f32_32x32x16_bf16(pa2, RET_PK(l2, h2), od, 0, 0, 0);
    od = __builtin_amdgcn_mfma_f32_32x32x16_bf16(pa3, RET_PK(l3, h3), od, 0, 0, 0);
}
__device__ __forceinline__ float gamma_log2(int h) { return log2f(1.0f - exp2f(-5.0f - (float)h)); }

__device__ __forceinline__ void loc_item(LAS unsigned char* lds, const bf16_t* Zk, const bf16_t* Zv, int ldz, float lg, float* KVo, int tid, int wave, int lane) {
    const int sr = tid >> 4, sc = (tid & 15) * 8, hi = lane >> 5, r32 = lane & 31;
#pragma unroll
    for (int m = 0; m < 4; ++m)
#pragma unroll
        for (int half = 0; half < 2; ++half) { const int key = 32 * half + sr, j = 64 * m + key;
            const bf16x8 kv = *(const bf16x8*)(Zk + (size_t)j * ldz + sc), vv = *(const bf16x8*)(Zv + (size_t)j * ldz + sc);
            const float dc = exp2f(lg * (float)(255 - j)); u32x4 w;
#pragma unroll
            for (int q = 0; q < 4; ++q) w[q] = cvtpk(__uint_as_float(((unsigned)(unsigned short)kv[2 * q]) << 16) * dc, __uint_as_float(((unsigned)(unsigned short)kv[2 * q + 1]) << 16) * dc);
            *(LAS u32x4*)(lds + m * 16384 + v_st(key, sc)) = w;
            *(LAS bf16x8*)(lds + 65536 + m * 16384 + v_st(key, sc)) = vv; }
    __syncthreads();
    const int eb = wave >> 1, db0 = 2 * (wave & 1);
    const int kb = (int)(uintptr_t)lds + v_rd_base(lane), vb = kb + 65536;
    f32x16 acc0 = f32x16{}, acc1 = f32x16{};
#define RET_LOC_STEP(M, KS) do { \
        const s16x4 al = tr_read<(M) * 16384 + 0 * 512 + (KS) * 4096>(vb + eb * 512), ah = tr_read<(M) * 16384 + 0 * 512 + (KS) * 4096 + 2048>(vb + eb * 512); \
        const s16x4 bl0 = tr_read<(M) * 16384 + (KS) * 4096>(kb + db0 * 512), bh0 = tr_read<(M) * 16384 + (KS) * 4096 + 2048>(kb + db0 * 512); \
        const s16x4 bl1 = tr_read<(M) * 16384 + 512 + (KS) * 4096>(kb + db0 * 512), bh1 = tr_read<(M) * 16384 + 512 + (KS) * 4096 + 2048>(kb + db0 * 512); \
        asm volatile("s_waitcnt lgkmcnt(0)" ::: "memory"); RET_SBAR(); \
        acc0 = __builtin_amdgcn_mfma_f32_32x32x16_bf16(RET_PK(al, ah), RET_PK(bl0, bh0), acc0, 0, 0, 0); \
        acc1 = __builtin_amdgcn_mfma_f32_32x32x16_bf16(RET_PK(al, ah), RET_PK(bl1, bh1), acc1, 0, 0, 0); } while (0)
#define RET_LOC_TILE(M) do { RET_LOC_STEP(M, 0); RET_LOC_STEP(M, 1); RET_LOC_STEP(M, 2); RET_LOC_STEP(M, 3); } while (0)
    RET_LOC_TILE(0); RET_LOC_TILE(1); RET_LOC_TILE(2); RET_LOC_TILE(3);
#undef RET_LOC_TILE
#undef RET_LOC_STEP
#pragma unroll
    for (int r = 0; r < 16; ++r) { const int e = 32 * eb + crow(r, hi); KVo[(size_t)e * 128 + 32 * db0 + r32] = acc0[r]; KVo[(size_t)e * 128 + 32 * (db0 + 1) + r32] = acc1[r]; }
    __syncthreads();
}

__device__ __forceinline__ void out_item(LAS unsigned char* lds, const bf16_t* Zq, const bf16_t* Zk, const bf16_t* Zv, const bf16_t* Zg, int ldz, const bf16_t* Rt, float lg, bf16_t* out, int ldo, int tid, int wave, int lane) {
    const int sr = tid >> 4, sc = (tid & 15) * 8, hi = lane >> 5, r32 = lane & 31;
#pragma unroll
    for (int m = 0; m < 4; ++m)
#pragma unroll
        for (int half = 0; half < 2; ++half) { const int key = 32 * half + sr, j = 64 * m + key;
            const bf16x8 kv = *(const bf16x8*)(Zk + (size_t)j * ldz + sc), vv = *(const bf16x8*)(Zv + (size_t)j * ldz + sc);
            *(LAS bf16x8*)(lds + m * 16384 + RET_KSWZ(key, sc * 2)) = kv;
            *(LAS bf16x8*)(lds + 65536 + m * 16384 + v_st(key, sc)) = vv; }
    const int rb = wave < 4 ? wave : ((wave & 3) < 2 ? 6 + (wave & 3) : 2 + (wave & 3)), n = rb >> 1;
    bf16x8 qr[8];
    { const bf16_t* qp = Zq + (size_t)(32 * rb + r32) * ldz + hi * 8;
#pragma unroll
      for (int d0 = 0; d0 < 8; ++d0) qr[d0] = *(const bf16x8*)(qp + d0 * 16); }
    f32x16 o[4];
#pragma unroll
    for (int ebk = 0; ebk < 4; ++ebk) { o[ebk] = f32x16{}; const bf16_t* rp = Rt + (size_t)(32 * ebk + r32) * 128 + hi * 8;
#pragma unroll
        for (int d0 = 0; d0 < 8; ++d0) { const bf16x8 rf = *(const bf16x8*)(rp + d0 * 16); o[ebk] = __builtin_amdgcn_mfma_f32_32x32x16_bf16(qr[d0], rf, o[ebk], 0, 0, 0); } }
#pragma unroll
    for (int r = 0; r < 16; ++r) { const float f = exp2f(lg * (float)(32 * rb + crow(r, hi) + 1));
#pragma unroll
        for (int ebk = 0; ebk < 4; ++ebk) o[ebk][r] *= f; }
    float ta[4], tb[4];
#pragma unroll
    for (int q = 0; q < 4; ++q) { ta[q] = exp2f(-lg * (float)q); tb[q] = exp2f(-lg * (float)(8 * q + 4 * hi)); }
    const float T32 = exp2f(-lg * 32.f);
    const int iq = 32 * rb + r32;
    const int vb = (int)(uintptr_t)lds + 65536 + v_rd_base(lane);
    __syncthreads();
    for (int m = 0; m <= n; ++m) {
        f32x16 p0, p1;
        qkt(p0, p1, lds + m * 16384, qr, r32, hi);
        if (m < n) { const float base = exp2f(lg * (float)(iq - 64 * m)); float b0[4], b1[4];
#pragma unroll
            for (int q = 0; q < 4; ++q) { b0[q] = base * tb[q]; b1[q] = b0[q] * T32; }
#pragma unroll
            for (int r = 0; r < 16; ++r) { p0[r] *= b0[r >> 2] * ta[r & 3]; p1[r] *= b1[r >> 2] * ta[r & 3]; } }
        else {
#pragma unroll
            for (int r = 0; r < 16; ++r) { const int d0_ = iq - 64 * m - crow(r, hi), d1_ = d0_ - 32;
                p0[r] *= exp2f(lg * (float)(d0_ < 0 ? -d0_ : d0_)); p1[r] *= exp2f(lg * (float)(d1_ < 0 ? -d1_ : d1_)); } }
        bf16x8 pa0, pa1, pa2, pa3;
#define RET_PK4(P, BASE, OUT) do { const unsigned a0 = cvtpk(P[BASE + 0], P[BASE + 1]), a1 = cvtpk(P[BASE + 2], P[BASE + 3]); \
        const unsigned b0 = cvtpk(P[BASE + 4], P[BASE + 5]), b1 = cvtpk(P[BASE + 6], P[BASE + 7]); \
        auto r0 = __builtin_amdgcn_permlane32_swap(a0, b0, false, false); auto r1 = __builtin_amdgcn_permlane32_swap(a1, b1, false, false); \
        u32x4 w = {r0[0], r1[0], r0[1], r1[1]}; OUT = *reinterpret_cast<bf16x8*>(&w); } while (0)
        RET_PK4(p0, 0, pa0); RET_PK4(p0, 8, pa1); RET_PK4(p1, 0, pa2); RET_PK4(p1, 8, pa3);
#undef RET_PK4
        const int vbm = vb + m * 16384;
        pv_one<0>(o[0], vbm, pa0, pa1, pa2, pa3); pv_one<1>(o[1], vbm, pa0, pa1, pa2, pa3); pv_one<2>(o[2], vbm, pa0, pa1, pa2, pa3); pv_one<3>(o[3], vbm, pa0, pa1, pa2, pa3);
    }
    int rbase = 32 * rb + 4 * hi; asm volatile("" : "+v"(rbase));
#pragma unroll
    for (int r = 0; r < 16; ++r) {
        float s = (o[0][r] + o[1][r]) + (o[2][r] + o[3][r]);
#pragma unroll
        for (int off = 1; off < 32; off <<= 1) s += __shfl_xor(s, off);
        const float mu = s * (1.f / 128.f);
        float v = 0.f;
#pragma unroll
        for (int ebk = 0; ebk < 4; ++ebk) { const float dl = o[ebk][r] - mu; v += dl * dl; }
#pragma unroll
        for (int off = 1; off < 32; off <<= 1) v += __shfl_xor(v, off);
        const float rs = rsqrtf(v * (1.f / 128.f) + EPS);
        const size_t row = (size_t)(rbase + (r & 3) + 8 * (r >> 2));
#pragma unroll
        for (int ebk = 0; ebk < 4; ++ebk) { const float gt = bf2f(Zg[row * ldz + 32 * ebk + r32]); const float sl = gt / (1.f + __expf(-gt)); out[row * ldo + 32 * ebk + r32] = f2bf(sl * (o[ebk][r] - mu) * rs); }
    }
    __syncthreads();
}
}

constexpr int NWAVES = 8;
constexpr int RING_BYTES = 131072, LDSCTL_OFF = RING_BYTES, MISC_OFF = LDSCTL_OFF + 320, TAB_OFF = LDSCTL_OFF + 512, RIDX_OFF = LDSCTL_OFF + 1024, MAXU = 8, LDS_BYTES = 147456;
static_assert(RIDX_OFF + MAXU * 1024 <= LDS_BYTES, "LDS map");
constexpr int CW_BAR = 4096;
constexpr int CW_CNT = 1024;
constexpr size_t CTL_BYTES = 1u << 20;

__device__ __forceinline__ float sel4(float a, float b, float c, float d, int i) { const float x = (i & 1) ? b : a, y = (i & 1) ? d : c; return (i & 2) ? y : x; }
__device__ __forceinline__ float wave_sum(float v) {
#pragma unroll
    for (int o = 1; o < 64; o <<= 1) v += __shfl_xor(v, o);
    return v;
}
template <class SrcF> __device__ __forceinline__ void tr_item(SrcF src, bf16* dst, int ldd, LAS float* scr, int lane) {
#pragma unroll 8
    for (int i = 0; i < 32; ++i) { const int kk = 2 * i + (lane >> 5); scr[kk * 33 + (lane & 31)] = src(kk, lane & 31); }
    LDS_WAIT(); asm volatile("" ::: "memory");
    const int c = lane & 7;
#pragma unroll
    for (int j = 0; j < 4; ++j) { const int n = (lane >> 3) + 8 * j; const LAS float* s = scr + (8 * c) * 33 + n;
        v4u o; o.x = pk2(s[0 * 33], s[1 * 33]); o.y = pk2(s[2 * 33], s[3 * 33]); o.z = pk2(s[4 * 33], s[5 * 33]); o.w = pk2(s[6 * 33], s[7 * 33]);
        *(GAS v4u*)(dst + (size_t)n * ldd + 8 * c) = o; }
    LDS_WAIT(); asm volatile("" ::: "memory");
}
__device__ __forceinline__ void rms_row_to_bf16(const float* xrow, bf16* orow, int lane) {
    const GAS f32x4* xr = (const GAS f32x4*)xrow + lane;
    f32x4 v[4]; float s = 0.f;
#pragma unroll
    for (int j = 0; j < 4; ++j) { v[j] = xr[64 * j]; s += (v[j].x * v[j].x + v[j].y * v[j].y) + (v[j].z * v[j].z + v[j].w * v[j].w); }
    const float rstd = rsqrtf(wave_sum(s) * (1.f / DM) + EPS);
    GAS unsigned long long* o8 = (GAS unsigned long long*)orow + lane;
#pragma unroll
    for (int j = 0; j < 4; ++j) o8[64 * j] = (unsigned long long)pk2(v[j].x * rstd, v[j].y * rstd) | ((unsigned long long)pk2(v[j].z * rstd, v[j].w * rstd) << 32);
}

typedef float f32x2v __attribute__((ext_vector_type(2)));
struct S5Tabs { f32x2v* lam1; f32x2v* lam16; f32x2v* bbg; };
__device__ __forceinline__ void s5_prep_item(int g, int i, const float* lre, const float* lim, const float* ldt, const float* bre, const float* bim, const float* cre, const float* cim, const float* dsk,
                                             bf16_t* W1t, bf16_t* W2t, S5Tabs T, LAS unsigned char* scr, int tid) {
    LAS f32x2v* pwl = (LAS f32x2v*)scr;
    LAS f32x2v* bbl = (LAS f32x2v*)(scr + 17 * 64 * 8);
    LAS f32x2v* cl = (LAS f32x2v*)(scr + 17 * 64 * 8 + 8192);
    if (tid < 64) { const int p = tid;
        const float re = lre[g * 64 + p], im = lim[g * 64 + p], dt = expf(ldt[g]);
        const float a = re * dt; const double th_d = (double)im * (double)dt;
        const float th = (float)(th_d - 6.283185307179586476925 * rint(th_d * 0.15915494309189533577));
        const float ea = expf(a), em1 = expm1f(a); float sn, cs; sincosf(th, &sn, &cs); const float sh = sinf(0.5f * th);
        const float lbr = ea * cs, lbi = ea * sn, mr = em1 * cs - 2.f * sh * sh, mi = ea * sn, den = re * re + im * im;
        const float fr = (mr * re + mi * im) / den, fi = (mi * re - mr * im) / den;
        for (int h = 0; h < 16; ++h) { const float br = bre[(g * 64 + p) * 16 + h], bi = bim[(g * 64 + p) * 16 + h]; const f32x2v v = (f32x2v){fr * br - fi * bi, fr * bi + fi * br}; bbl[p * 16 + h] = v; if (i == 0) T.bbg[(g * 64 + p) * 16 + h] = v; }
        float xr = 1.f, xi = 0.f;
        for (int d = 0; d <= 16; ++d) { pwl[d * 64 + p] = (f32x2v){xr, xi}; const float nr = xr * lbr - xi * lbi, ni = xr * lbi + xi * lbr; xr = nr; xi = ni; }
        if (i == 0) { T.lam1[g * 64 + p] = (f32x2v){lbr, lbi}; T.lam16[g * 64 + p] = pwl[16 * 64 + p]; }
    }
    for (int e = tid; e < 1024; e += NWAVES * 64) cl[e] = (f32x2v){cre[g * 1024 + e], cim[g * 1024 + e]};
    __syncthreads();
    bf16_t* w2 = W2t + (size_t)g * 256 * 384; bf16_t* w1 = W1t + (size_t)g * 256 * 256;
    for (int e = tid; e < 1024; e += NWAVES * 64) { const int h = e >> 6, p = e & 63; const f32x2v c = cl[e], w = pwl[(i + 1) * 64 + p];
        w2[(size_t)(i * 16 + h) * 384 + p] = f2bf(c.x * w.x - c.y * w.y); w2[(size_t)(i * 16 + h) * 384 + 64 + p] = f2bf(-(c.x * w.y + c.y * w.x)); }
    for (int e = tid; e < 4096; e += NWAVES * 64) { const int h = e >> 8, j = (e >> 4) & 15, h2 = e & 15; float v = 0.f;
        if (j <= i) { const int d = i - j;
            for (int p = 0; p < 64; ++p) { const f32x2v c = cl[h * 64 + p], w = pwl[d * 64 + p], b = bbl[p * 16 + h2]; const float tr = c.x * w.x - c.y * w.y, ti = c.x * w.y + c.y * w.x; v += tr * b.x - ti * b.y; }
            if (j == i && h == h2) v += dsk[g * 16 + h]; }
        w2[(size_t)(i * 16 + h) * 384 + 128 + j * 16 + h2] = f2bf(v); }
    for (int e = tid; e < 1024; e += NWAVES * 64) { const int p = e >> 4, h2 = e & 15; const f32x2v w = pwl[(15 - i) * 64 + p], b = bbl[p * 16 + h2];
        w1[(size_t)p * 256 + i * 16 + h2] = f2bf(w.x * b.x - w.y * b.y); w1[(size_t)(64 + p) * 256 + i * 16 + h2] = f2bf(w.x * b.y + w.y * b.x); }
    for (int e = tid; e < 2048; e += NWAVES * 64) w1[(size_t)(128 + (e >> 4)) * 256 + i * 16 + (e & 15)] = 0;
    __syncthreads();
}
template <class UM> __device__ __forceinline__ void s5_scan_item(int b, int g, const float* loc, bf16_t* A2, S5Tabs T, UM umeta, LAS unsigned char* scr, int tid) {
    LAS f32x2v* tot = (LAS f32x2v*)scr;
    const int p = tid & 63, sg = tid >> 6;
    const f32x2v l1 = T.lam1[g * 64 + p], l16 = T.lam16[g * 64 + p];
    float x0r = 0.f, x0i = 0.f;
    for (int j = 0; j < NMETA; ++j) { float sr = 0.f, si = 0.f;
#pragma unroll
        for (int h = 0; h < 16; ++h) { const f32x2v bv = T.bbg[(g * 64 + p) * 16 + h]; const float uv = umeta(j, h); sr = fmaf(bv.x, uv, sr); si = fmaf(bv.y, uv, si); }
        const float nr = l1.x * x0r - l1.y * x0i + sr, ni = l1.x * x0i + l1.y * x0r + si; x0r = nr; x0i = ni; }
    const float* lp = loc + ((size_t)g * 2048 + b * 256 + sg * 32) * 128 + p;
    float lr[32], li[32];
#pragma unroll
    for (int q = 0; q < 32; ++q) { lr[q] = lp[(size_t)q * 128]; li[q] = lp[(size_t)q * 128 + 64]; }
    float xr = 0.f, xi = 0.f;
#pragma unroll
    for (int q = 0; q < 32; ++q) { const float nr = l16.x * xr - l16.y * xi + lr[q], ni = l16.x * xi + l16.y * xr + li[q]; xr = nr; xi = ni; lr[q] = xr; li[q] = xi; }
    tot[sg * 64 + p] = (f32x2v){xr, xi};
    float Lr = l16.x, Li = l16.y;
#pragma unroll
    for (int q = 0; q < 5; ++q) { const float nr = Lr * Lr - Li * Li, ni = 2.f * Lr * Li; Lr = nr; Li = ni; }
    __syncthreads();
    float cr = x0r, ci = x0i;
    for (int s = 0; s < sg; ++s) { const f32x2v t = tot[s * 64 + p]; const float nr = Lr * cr - Li * ci + t.x, ni = Lr * ci + Li * cr + t.y; cr = nr; ci = ni; }
    bf16_t* ap = A2 + ((size_t)g * 2048 + b * 256 + sg * 32) * 384 + p;
    float pr = 1.f, pi = 0.f;
#pragma unroll
    for (int q = 0; q < 32; ++q) { float Xr = pr * cr - pi * ci, Xi = pr * ci + pi * cr; if (q > 0) { Xr += lr[q - 1]; Xi += li[q - 1]; }
        ap[(size_t)q * 384] = f2bf(Xr); ap[(size_t)q * 384 + 64] = f2bf(Xi);
        const float nr = pr * l16.x - pi * l16.y, ni = pr * l16.y + pi * l16.x; pr = nr; pi = ni; }
    __syncthreads();
}

struct Args { const float* x; const float* w_in; const float* gmix; const float* w_out; const float* lre; const float* lim; const float* ldt; const float* sbre; const float* sbim; const float* scre; const float* scim; const float* sdsk; const float* w_glu; const float* meta; const float* gffn; const float* wrg; const float* brg; const float* wre; const float* bre; const float* wgate; const float* wup; const float* wdown; const float* gfin;
              float* out; unsigned char* ws; int ph_lo, ph_hi, li, pad; };
constexpr size_t MiB = 1u << 20;
constexpr size_t WS_CTL = 0, WS_WTIN = 2 * MiB, WS_WTOUT = 10 * MiB, WS_WGU = 12 * MiB, WS_WDT = 28 * MiB, WS_IDX = 52 * MiB, WS_WLO = 55 * MiB, WS_WHI = 58 * MiB, WS_RS = 61 * MiB,
                 WS_XN = 64 * MiB  , WS_MIXED = 128 * MiB  , WS_Z = 192 * MiB, WS_REST = 401 * MiB, WS_KV = 128 * MiB  ,
                 WS_A2 = 401 * MiB, WS_LOC = 425 * MiB, WS_YTOK = 441 * MiB, WS_W1T = 457 * MiB, WS_W2T = 459 * MiB, WS_WGLUT = 462 * MiB, WS_S5TAB = 463 * MiB, WS_CS = 464 * MiB, WS_ZM = 466 * MiB, WS_END = 467 * MiB;
static_assert(WS_Z + (size_t)T_REAL * NIN * 2 <= WS_REST, "ws map");

__global__ void __launch_bounds__(NWAVES * 64, 2) mega(Args args) {
    extern __shared__ __attribute__((aligned(16))) unsigned char lds_raw[];
    LAS unsigned char* lds = (LAS unsigned char*)lds_raw;
    volatile LAS unsigned* MISC = (volatile LAS unsigned*)(lds + MISC_OFF);
    LAS int* tab = (LAS int*)(lds + TAB_OFF); LAS int* utab = tab + 80;
    LAS int* ridx = (LAS int*)(lds + RIDX_OFF);
    const int tid = threadIdx.x, lane = tid & 63, wave = __builtin_amdgcn_readfirstlane(tid >> 6);
    const int G = gridDim.x;
    unsigned char* ws = args.ws;
    gu32* ctl = (gu32*)(ws + WS_CTL);
    bf16* WtIn = (bf16*)(ws + WS_WTIN); bf16* WtOut = (bf16*)(ws + WS_WTOUT); bf16* Wgu = (bf16*)(ws + WS_WGU); bf16* WdT = (bf16*)(ws + WS_WDT);
    int* IDX = (int*)(ws + WS_IDX); float* WLO = (float*)(ws + WS_WLO); float* WHI = (float*)(ws + WS_WHI); float* RSV = (float*)(ws + WS_RS);
    bf16* XN = (bf16*)(ws + WS_XN); bf16* RT = (bf16*)(ws + WS_XN); float* KV = (float*)(ws + WS_KV);
    bf16* A2 = (bf16*)(ws + WS_A2); float* LOC = (float*)(ws + WS_LOC); bf16* YTOK = (bf16*)(ws + WS_YTOK); bf16* W1T = (bf16*)(ws + WS_W1T); bf16* W2T = (bf16*)(ws + WS_W2T); bf16* WgluT = (bf16*)(ws + WS_WGLUT); float* CS = (float*)(ws + WS_CS); float* ZM = (float*)(ws + WS_ZM);
    S5Tabs TB{(f32x2v*)(ws + WS_S5TAB), (f32x2v*)(ws + WS_S5TAB + 16384), (f32x2v*)(ws + WS_S5TAB + 32768)}; bf16* H1B = (bf16*)(ws + WS_XN); bf16* MIXED = (bf16*)(ws + WS_MIXED); bf16* HB = (bf16*)(ws + WS_MIXED); bf16* Z = (bf16*)(ws + WS_Z);
    for (int u = tid; u < (LDS_BYTES - LDSCTL_OFF) / 4; u += NWAVES * 64) ((LAS unsigned*)(lds + LDSCTL_OFF))[u] = 0u;
    __syncthreads();
    XcdBarrier bar = xcd_barrier_post((unsigned*)(ctl + CW_BAR) + args.li * XCD_BAR_WORDS, MISC + 8);
    const int lo = args.ph_lo, hi = args.ph_hi;
    const int gw = blockIdx.x * NWAVES + wave, NGW = G * NWAVES;
#define IN(k) (lo <= (k) && (k) < hi)
#define BOTH(k) (IN(k) && IN((k) + 1))
    if (IN(0)) {
        LAS float* scr = (LAS float*)(lds + wave * 16384);
        constexpr int I_IN = (DM / 64) * (NIN / 32), I_OUT = (DM / 64) * (DM / 32), I_GU = 16 * 16 * 16, I_DN = 24 * 2 * 4 * 32;
        for (int it = gw; it < I_IN + I_OUT + I_GU + I_DN; it += NGW) {
            int r = it;
            if (r < I_IN) { const int nblk = NIN / 32, k0 = 64 * (r / nblk), n0 = 32 * (r % nblk); const float* W = args.w_in; const float* gs = args.gmix;
                tr_item([=](int kk, int nn) { const int ns = n0 + nn; int no = ns; float sc = 1.f; if (ns >= ZQ && ns < ZV) { const int sp = (ns - ZQ) & 127; no = (ns - sp) + (sp >> 1) + 64 * (sp & 1); if (ns >= ZK) sc = 0.08838834764831845f; }
                    return W[(size_t)(k0 + kk) * NIN + no] * gs[k0 + kk] * sc; }, WtIn + (size_t)n0 * DM + k0, DM, scr, lane); continue; } r -= I_IN;
            if (r < I_OUT) { const int nblk = DM / 32, k0 = 64 * (r / nblk), n0 = 32 * (r % nblk); const float* W = args.w_out;
                tr_item([=](int kk, int nn) { return W[(size_t)(k0 + kk) * DM + n0 + nn]; }, WtOut + (size_t)n0 * DM + k0, DM, scr, lane); continue; } r -= I_OUT;
            if (r < I_GU) { const int e = r >> 8, k0 = 64 * ((r >> 4) & 15), cb = r & 15; const float* Wg = args.wgate + (size_t)e * DM * 256; const float* Wu = args.wup + (size_t)e * DM * 256; const float* gs = args.gffn;
                tr_item([=](int kk, int nn) { const float* W = (nn >> 4) ? Wu : Wg; return W[(size_t)(k0 + kk) * 256 + cb * 16 + (nn & 15)] * gs[k0 + kk]; }, Wgu + ((size_t)e * 512 + cb * 32) * DM + k0, DM, scr, lane); continue; } r -= I_GU;
            { const int cls = r >> 8, half = (r >> 7) & 1, k0 = 64 * ((r >> 5) & 3), n0 = 32 * (r & 31);
              const int gi = cls / 6, p = cls - gi * 6; const int ea = p < 3 ? 0 : (p < 5 ? 1 : 2), eb = p < 3 ? p + 1 : (p < 5 ? p - 1 : 3); const int e = gi * 4 + (half ? eb : ea);
              const float* W = args.wdown + (size_t)e * 256 * DM;
              tr_item([=](int kk, int nn) { return W[(size_t)(k0 + kk) * DM + n0 + nn]; }, WdT + ((size_t)cls * 1024 + n0) * 512 + half * 256 + k0, 512, scr, lane); }
        }
        for (int it = gw; it < 32; it += NGW) { const int k0 = 64 * (it >> 3), n0 = 32 * (it & 7); const float* W = args.w_glu;
            tr_item([=](int kk, int nn) { return W[(size_t)(k0 + kk) * 256 + n0 + nn]; }, WgluT + (size_t)n0 * 256 + k0, 256, scr, lane); }
        for (int m = gw; m < T_REAL; m += NGW) rms_row_to_bf16(args.x + (size_t)m * DM, XN + (size_t)m * DM, lane);
        __syncthreads();
        for (int it = blockIdx.x; it < 256; it += G) s5_prep_item(it >> 4, it & 15, args.lre, args.lim, args.ldt, args.sbre, args.sbim, args.scre, args.scim, args.sdsk, W1T, W2T, TB, lds, tid);
        for (int i = blockIdx.x * 512 + tid; i < 24 * 32768; i += G * 512) IDX[i] = 0;
        for (int e = blockIdx.x * 512 + tid; e < SEQ * 64; e += G * 512) { const int sq = e >> 6, i = e & 63; const double ang = (double)(NMETA + sq) * c_invfreq[i];
            const double red = ang - 6.283185307179586476925 * rint(ang * 0.15915494309189533577); float sn, cs; sincosf((float)red, &sn, &cs); CS[(size_t)e * 2] = cs; CS[(size_t)e * 2 + 1] = sn; }
        {
            const int r = tid >> 5, kq = tid & 31; const float* mr = args.meta + (size_t)r * DM; float ss = 0.f;
            for (int k = kq; k < DM; k += 32) ss += mr[k] * mr[k];
#pragma unroll
            for (int o = 1; o < 32; o <<= 1) ss += __shfl_xor(ss, o);
            const float rstd = rsqrtf(ss * (1.f / DM) + EPS);
            for (int n = blockIdx.x; n < NIN; n += G) { float sacc = 0.f;
                for (int k = kq; k < DM; k += 32) sacc = fmaf(mr[k] * args.gmix[k], args.w_in[(size_t)k * NIN + n], sacc);
#pragma unroll
                for (int o = 1; o < 32; o <<= 1) sacc += __shfl_xor(sacc, o);
                if (kq == 0) ZM[(size_t)r * NIN + n] = sacc * rstd; } }
        if (BOTH(0)) xcd_barrier(bar);
    }
    if (IN(1)) {
        pg8::Gemm g{DM, DM, DM}; pg8::StaticOrder S; S.init(T_REAL, NIN, G, (int)blockIdx.x);
        S.A0 = (const char*)XN; S.B0 = (const char*)WtIn; S.strideA = (size_t)256 * DM * 2; S.strideB = (size_t)256 * DM * 2;
        pg8::EpiZ E{Z, NIN, A2, CS};
        pg8::gemm_phase<pg8::EpiZ, pg8::StaticOrder, PG8_ALIGN, PG8_SP2>(lds, g, S, E);
        if (BOTH(1)) xcd_barrier(bar);
    }
    int rit0, rits, rnit;
    if (G == 256) { if (blockIdx.x < 128) { rit0 = 512 + blockIdx.x; rits = 128; rnit = 2; } else { rit0 = blockIdx.x - 128; rits = 128; rnit = 4; } }
    else { rit0 = blockIdx.x; rits = G; rnit = blockIdx.x < 768 ? (767 - (int)blockIdx.x) / G + 1 : 0; }
    if (IN(2)) {
        { pg8::Gemm g{256, 384, 256}; pg8::S5Order S{G, (int)blockIdx.x, (const char*)(A2 + 128), (const char*)W1T, (size_t)2048 * 384 * 2, (size_t)256 * 256 * 2};
          pg8::EpiS5Loc E{LOC};
          pg8::gemm_phase<pg8::EpiS5Loc, pg8::S5Order, PG8_ALIGN, PG8_SP2>(lds, g, S, E); }
        __syncthreads();
        for (int q = 0; q < rnit; ++q) { const int item = rit0 + q * rits; const int bh = item >> 4, S = item & 15, b = bh / 6, h = bh - b * 6; const size_t row0 = (size_t)b * SEQ + S * 256;
            ret::loc_item(lds, Z + row0 * NIN + ZK + h * 128, Z + row0 * NIN + ZV + h * 128, NIN, ret::gamma_log2(h), KV + (size_t)item * 16384, tid, wave, lane); }
        for (int h = (int)blockIdx.x - (G - 6); h >= 0 && h < 6; h += G) {
            LAS float* kr = (LAS float*)lds; LAS float* vm = kr + 16 * 128; const float lg = ret::gamma_log2(h);
            for (int e = tid; e < 16 * 64; e += NWAVES * 64) { const int mt = e >> 6, i = e & 63; float sn, cs; sincosf((float)((double)mt * c_invfreq[i]), &sn, &cs);
                const float t1 = ZM[(size_t)mt * NIN + ZK + h * 128 + i], t2 = ZM[(size_t)mt * NIN + ZK + h * 128 + i + 64], dc = exp2f(lg * (float)(15 - mt)) * 0.08838834764831845f;
                kr[mt * 128 + 2 * i] = (t1 * cs - t2 * sn) * dc; kr[mt * 128 + 2 * i + 1] = (t2 * cs + t1 * sn) * dc; }
            for (int e = tid; e < 16 * 128; e += NWAVES * 64) vm[e] = ZM[(size_t)(e >> 7) * NIN + ZV + h * 128 + (e & 127)];
            __syncthreads();
            for (int ed = tid; ed < 16384; ed += NWAVES * 64) { const int e = ed >> 7, d = ed & 127; float sacc = 0.f;
#pragma unroll
                for (int mt = 0; mt < NMETA; ++mt) sacc = fmaf(vm[mt * 128 + e], kr[mt * 128 + d], sacc);
                KV[(size_t)(768 + h) * 16384 + ed] = sacc; }
            __syncthreads(); }
        if (BOTH(2)) xcd_barrier(bar);
    }
    if (IN(3)) {
        for (int it = blockIdx.x; it < 128; it += G) { const int b = it >> 4, g = it & 15; const float* zm = ZM + g * 16;
            s5_scan_item(b, g, LOC, A2, TB, [=](int j, int h) { return zm[(size_t)j * NIN + h]; }, lds, tid); }
        for (int c = blockIdx.x * (NWAVES * 64) + tid; c < 48 * 16384; c += G * NWAVES * 64) { const int bh = c >> 14, ed = c & 16383, h = bh % 6;
            const float g256 = exp2f(256.f * ret::gamma_log2(h)); float r = KV[(size_t)(768 + h) * 16384 + ed]; float l[16];
#pragma unroll
            for (int S = 0; S < 16; ++S) l[S] = KV[(size_t)(bh * 16 + S) * 16384 + ed];
#pragma unroll
            for (int S = 0; S < 16; ++S) { RT[(size_t)(bh * 16 + S) * 16384 + ed] = f2bf(r); r = g256 * r + l[S]; } }
        if (BOTH(3)) xcd_barrier(bar);
    }
    if (IN(4)) {
        { pg8::Gemm g{384, 384, 384}; pg8::S5Order S{G, (int)blockIdx.x, (const char*)A2, (const char*)W2T, (size_t)2048 * 384 * 2, (size_t)256 * 384 * 2};
          pg8::EpiS5Y E{YTOK};
          pg8::gemm_phase<pg8::EpiS5Y, pg8::S5Order, PG8_ALIGN, PG8_SP2>(lds, g, S, E); }
        __syncthreads();
        for (int q = 0; q < rnit; ++q) { const int item = rit0 + q * rits; const int bh = item >> 4, S = item & 15, b = bh / 6, h = bh - b * 6; const size_t row0 = (size_t)b * SEQ + S * 256; const bf16* zr = Z + row0 * NIN + h * 128;
            ret::out_item(lds, zr + ZQ, zr + ZK, zr + ZV, zr + ZG, NIN, RT + (size_t)item * 16384, ret::gamma_log2(h), MIXED + row0 * DM + 256 + h * 128, DM, tid, wave, lane); }
        if (BOTH(4)) xcd_barrier(bar);
    }
    if (IN(5)) {
        pg8::Gemm g{256, 256, 256}; pg8::StaticOrder S; S.init(T_REAL, 256, G, (int)blockIdx.x);
        S.A0 = (const char*)YTOK; S.B0 = (const char*)WgluT; S.strideA = (size_t)256 * 256 * 2; S.strideB = 0;
        pg8::EpiGlu E{YTOK, MIXED, DM};
        pg8::gemm_phase<pg8::EpiGlu, pg8::StaticOrder, PG8_ALIGN, PG8_SP2>(lds, g, S, E);
        if (BOTH(5)) xcd_barrier(bar);
    }
    if (IN(6)) {
        pg8::Gemm g{DM, DM, DM}; pg8::StaticOrder S; S.init(T_REAL, DM, G, (int)blockIdx.x);
        S.A0 = (const char*)MIXED; S.B0 = (const char*)WtOut; S.strideA = (size_t)256 * DM * 2; S.strideB = (size_t)256 * DM * 2;
        pg8::EpiRes2 E{args.x, args.out, H1B, DM};
        pg8::gemm_phase<pg8::EpiRes2, pg8::StaticOrder, PG8_ALIGN, PG8_SP2>(lds, g, S, E);
        if (BOTH(6)) xcd_barrier(bar);
    }
    if (IN(7)) {
        LAS float* wl = (LAS float*)lds;
        LAS int* s_cls = (LAS int*)(lds + 81920); LAS float* s_wlo = (LAS float*)(lds + 81920 + 512); LAS float* s_whi = (LAS float*)(lds + 81920 + 1024); LAS float* s_rs = (LAS float*)(lds + 81920 + 1536);
        LAS int* s_base = (LAS int*)(lds + 81920 + 2048);
        for (int k = tid; k < DM; k += NWAVES * 64) {
            const float4 w = *(const float4*)(args.wrg + (size_t)k * 4); wl[0 * DM + k] = w.x; wl[1 * DM + k] = w.y; wl[2 * DM + k] = w.z; wl[3 * DM + k] = w.w;
#pragma unroll
            for (int g = 0; g < 4; ++g) { const float4 we = *(const float4*)(args.wre + ((size_t)g * DM + k) * 4); wl[(4 + 4 * g) * DM + k] = we.x; wl[(5 + 4 * g) * DM + k] = we.y; wl[(6 + 4 * g) * DM + k] = we.z; wl[(7 + 4 * g) * DM + k] = we.w; }
        }
        __syncthreads();
        for (int t0 = blockIdx.x * 128; t0 < T_REAL; t0 += G * 128) {
            for (int q = 0; q < 8; ++q) {
                const int tl = wave * 16 + q * 2;
                f32x4 a[2][4]; float rsv[2];
#pragma unroll
                for (int tk = 0; tk < 2; ++tk) {
                    const GAS f32x4* hp = (const GAS f32x4*)(args.out + (size_t)(t0 + tl + tk) * DM) + lane; float ss = 0.f;
#pragma unroll
                    for (int j = 0; j < 4; ++j) { a[tk][j] = hp[64 * j]; ss += (a[tk][j].x * a[tk][j].x + a[tk][j].y * a[tk][j].y) + (a[tk][j].z * a[tk][j].z + a[tk][j].w * a[tk][j].w); }
                    rsv[tk] = rsqrtf(wave_sum(ss) * (1.f / DM) + EPS);
                }
#pragma unroll
                for (int j = 0; j < 4; ++j) { const f32x4 gv = ((const GAS f32x4*)args.gffn)[lane + 64 * j]; a[0][j] = a[0][j] * gv * rsv[0]; a[1][j] = a[1][j] * gv * rsv[1]; }
                float lg[2][20];
#pragma unroll
                for (int c = 0; c < 20; ++c) {
                    float s0 = 0.f, s1 = 0.f;
#pragma unroll
                    for (int j = 0; j < 4; ++j) { const f32x4 w = *(const LAS f32x4*)(wl + c * DM + lane * 4 + 256 * j);
                        s0 += (a[0][j].x * w.x + a[0][j].y * w.y) + (a[0][j].z * w.z + a[0][j].w * w.w); s1 += (a[1][j].x * w.x + a[1][j].y * w.y) + (a[1][j].z * w.z + a[1][j].w * w.w); }
                    lg[0][c] = wave_sum(s0); lg[1][c] = wave_sum(s1);
                }
                if (lane < 2) {
                    float L[20];
#pragma unroll
                    for (int c = 0; c < 20; ++c) L[c] = lane ? lg[1][c] : lg[0][c];
                    float l4[4];
#pragma unroll
                    for (int c = 0; c < 4; ++c) l4[c] = L[c] + args.brg[c];
                    int gi = 0; float gm = l4[0];
#pragma unroll
                    for (int g = 1; g < 4; ++g) if (l4[g] > gm) { gm = l4[g]; gi = g; }
                    float den = 0.f;
#pragma unroll
                    for (int g = 0; g < 4; ++g) den += expf(l4[g] - gm);
                    const float gwt = 1.f / den;
                    float v[4];
#pragma unroll
                    for (int e = 0; e < 4; ++e) v[e] = sel4(L[4 + e], L[8 + e], L[12 + e], L[16 + e], gi) + args.bre[gi * 4 + e];
                    int i1 = 0; float m1 = v[0];
#pragma unroll
                    for (int e = 1; e < 4; ++e) if (v[e] > m1) { m1 = v[e]; i1 = e; }
                    int i2 = -1; float m2 = -3.0e38f;
#pragma unroll
                    for (int e = 0; e < 4; ++e) if (e != i1 && v[e] > m2) { m2 = v[e]; i2 = e; }
                    const float w1 = 1.f / (1.f + expf(m2 - m1)), w2 = 1.f - w1;
                    const int ea = i1 < i2 ? i1 : i2, eb = i1 < i2 ? i2 : i1;
                    const int p = ea == 0 ? eb - 1 : (ea == 1 ? eb + 1 : 5);
                    s_cls[tl + lane] = gi * 6 + p; s_wlo[tl + lane] = gwt * (i1 < i2 ? w1 : w2); s_whi[tl + lane] = gwt * (i1 < i2 ? w2 : w1); s_rs[tl + lane] = lane ? rsv[1] : rsv[0];
                }
            }
            __syncthreads();
            if (tid < 24) { int n = 0; for (int j = 0; j < 128; ++j) n += (s_cls[j] == tid) ? 1 : 0; s_base[tid] = n ? (int)__hip_atomic_fetch_add(ctl + CW_CNT + tid, (unsigned)n, RLX_AGENT) : 0; }
            __syncthreads();
            if (tid < 128) { const int c = s_cls[tid]; int rk = 0; for (int j = 0; j < tid; ++j) rk += (s_cls[j] == c) ? 1 : 0; const size_t pos = (size_t)c * 32768 + s_base[c] + rk;
                IDX[pos] = t0 + tid; WLO[pos] = s_wlo[tid]; WHI[pos] = s_whi[tid]; RSV[pos] = s_rs[tid]; }
            __syncthreads();
        }
        if (BOTH(7)) xcd_barrier(bar);
    }
    if (IN(8) || IN(9)) {
        if (tid == 0) { int tb = 0; for (int c = 0; c < 24; ++c) { const int n = (int)__hip_atomic_load(ctl + CW_CNT + c, RLX_AGENT); tab[c] = n; tab[32 + c] = tb; tb += (n + 255) >> 8; } tab[32 + 24] = tb; tab[64] = tb;
            for (int i = 0; i < MAXU; ++i) { const int L = i * G + (int)blockIdx.x; int t = -1, pn = 0, cls = 0, pos0 = 0;
                if (L < tb * 4) { t = L >> 2; pn = L & 3; for (int q = 1; q < 24; ++q) cls += (t >= tab[32 + q]) ? 1 : 0; pos0 = 256 * (t - tab[32 + cls]); }
                utab[i * 4] = t; utab[i * 4 + 1] = pn; utab[i * 4 + 2] = cls; utab[i * 4 + 3] = pos0; } }
        __syncthreads();
    }
    if (IN(8)) {
        pg8::MoeOrder S{utab, 0, (const char*)H1B, (const char*)Wgu};
        for (int i = 0; i < MAXU; ++i) { pg8::Unit u; if (!S.next(i, u)) break; if (tid < 256) ridx[i * 256 + tid] = IDX[(size_t)u.aux0 * 32768 + u.aux1 + tid]; }
        __syncthreads();
        pg8::Gemm g{DM, DM, DM};
        pg8::EpiMoeH E{HB, WLO, WHI, RSV};
        pg8::gemm_phase<pg8::EpiMoeH, pg8::MoeOrder, PG8_ALIGN, PG8_SP2, true>(lds, g, S, E, ridx);
        if (BOTH(8)) xcd_barrier(bar);
    }
    if (IN(9)) {
        pg8::MoeOrder S{utab, 1, (const char*)HB, (const char*)WdT};
        pg8::Gemm g{512, 512, 512};
        pg8::EpiMoeDown E{args.out, IDX, tab};
        pg8::gemm_phase<pg8::EpiMoeDown, pg8::MoeOrder, PG8_ALIGN, PG8_SP2>(lds, g, S, E);
        if (BOTH(9)) xcd_barrier(bar);
    }
    if (IN(10)) {
        for (int m = gw; m < T_REAL; m += NGW) {
            GAS f32x4* xr = (GAS f32x4*)(args.out + (size_t)m * DM) + lane; const GAS f32x4* gr = (const GAS f32x4*)args.gfin + lane;
            f32x4 v[4]; float s = 0.f;
#pragma unroll
            for (int j = 0; j < 4; ++j) { v[j] = xr[64 * j]; s += (v[j].x * v[j].x + v[j].y * v[j].y) + (v[j].z * v[j].z + v[j].w * v[j].w); }
            const float rstd = rsqrtf(wave_sum(s) * (1.f / DM) + EPS);
#pragma unroll
            for (int j = 0; j < 4; ++j) xr[64 * j] = v[j] * rstd * gr[64 * j];
        }
    }
#undef IN
#undef BOTH
}

extern "C" void kernel_launch(void* const* d_in, const int* in_sizes, int n_in, void* d_out, int out_size, void* d_ws, size_t ws_size, hipStream_t stream) {
    (void)in_sizes; (void)n_in; (void)out_size;
    unsigned char* ws = (unsigned char*)d_ws;
    static int grid = 0;
    if (grid == 0) {
        int dev = 0, cus = 0, per_cu = 0;
        (void)hipGetDevice(&dev); (void)hipDeviceGetAttribute(&cus, hipDeviceAttributeMultiprocessorCount, dev);
        (void)hipFuncSetAttribute((const void*)mega, hipFuncAttributeMaxDynamicSharedMemorySize, LDS_BYTES);
        (void)hipOccupancyMaxActiveBlocksPerMultiprocessor(&per_cu, (const void*)mega, NWAVES * 64, LDS_BYTES);
        (void)hipGetLastError();
        if (per_cu < 1) fprintf(stderr, "kernel_launch: occupancy query reports %d blocks per CU\n", per_cu);
        grid = cus > 0 ? cus : 256;
        if (WS_END > ws_size) fprintf(stderr, "kernel_launch: workspace too small: need %zu have %zu\n", (size_t)WS_END, ws_size);
    }
    (void)hipMemsetAsync(ws + WS_CTL, 0, CTL_BYTES, stream);
    Args a{};
    a.x = (const float*)d_in[0]; a.meta = (const float*)d_in[1]; a.gmix = (const float*)d_in[2]; a.w_in = (const float*)d_in[3];
    a.lre = (const float*)d_in[4]; a.lim = (const float*)d_in[5]; a.ldt = (const float*)d_in[6]; a.sbre = (const float*)d_in[7]; a.sbim = (const float*)d_in[8];
    a.scre = (const float*)d_in[9]; a.scim = (const float*)d_in[10]; a.sdsk = (const float*)d_in[11]; a.w_glu = (const float*)d_in[12]; a.w_out = (const float*)d_in[13];
    a.gffn = (const float*)d_in[14]; a.wrg = (const float*)d_in[15]; a.brg = (const float*)d_in[16]; a.wre = (const float*)d_in[17]; a.bre = (const float*)d_in[18];
    a.wgate = (const float*)d_in[19]; a.wup = (const float*)d_in[20]; a.wdown = (const float*)d_in[21]; a.gfin = (const float*)d_in[22];
    a.out = (float*)d_out; a.ws = ws; a.ph_lo = 0; a.ph_hi = 11; a.li = 0;
    hipLaunchKernelGGL(mega, dim3(grid), dim3(NWAVES * 64), LDS_BYTES, stream, a);
}
```

```cpp
#include <hip/hip_runtime.h>
#include <stdint.h>
#include <cstdio>

#define T_REAL 32768
#define SEQ 4096
#define NBATCH 8
#define DM 1024
#define NIN 3328
#define NMETA 16
#define MROWS (T_REAL + NMETA)
#define EPS 1e-6f
#define ZU 0
#define ZQ 256
#define ZK 1024
#define ZV 1792
#define ZG 2560

__constant__ double c_invfreq[64] = {1.0, 0.8659643233600653, 0.7498942093324559, 0.6493816315762113, 0.5623413251903491, 0.4869675251658631, 0.4216965034285822, 0.3651741272548377, 0.31622776601683794, 0.27384196342643613, 0.23713737056616552, 0.2053525026457146, 0.1778279410038923, 0.1539926526059492, 0.1333521432163324, 0.11547819846894582, 0.1, 0.08659643233600653, 0.07498942093324558, 0.06493816315762113, 0.05623413251903491, 0.04869675251658631, 0.042169650342858224, 0.03651741272548377, 0.03162277660168379, 0.027384196342643614, 0.023713737056616554, 0.02053525026457146, 0.01778279410038923, 0.01539926526059492, 0.01333521432163324, 0.011547819846894581, 0.01, 0.008659643233600654, 0.007498942093324558, 0.006493816315762113, 0.005623413251903491, 0.004869675251658631, 0.004216965034285823, 0.003651741272548377, 0.0031622776601683794, 0.0027384196342643613, 0.0023713737056616554, 0.002053525026457146, 0.0017782794100389228, 0.001539926526059492, 0.001333521432163324, 0.0011547819846894581, 0.001, 0.0008659643233600654, 0.0007498942093324559, 0.0006493816315762113, 0.0005623413251903491, 0.0004869675251658631, 0.00042169650342858224, 0.0003651741272548377, 0.00031622776601683794, 0.0002738419634264361, 0.00023713737056616554, 0.0002053525026457146, 0.00017782794100389227, 0.0001539926526059492, 0.0001333521432163324, 0.00011547819846894582};

namespace pg8 {
#define PG8_LAS __attribute__((address_space(3)))
typedef unsigned short bf16_t;
typedef short bf16x8 __attribute__((ext_vector_type(8)));
typedef float f32x4 __attribute__((ext_vector_type(4)));
typedef unsigned u32x4 __attribute__((ext_vector_type(4)));
constexpr int BM = 256, BK = 64, HALF = 128, HTB = HALF * BK * 2  , STAGE_BYTES = 8 * HTB, NXCD = 8, WGM = 8;

__host__ __device__ __forceinline__ int lds_byte(int r, int c) { const int st = (r >> 4) * 2 + (c >> 5), rr = r & 15, cc = c & 31, ob = rr * 64 + cc * 2; return st * 1024 + (ob ^ (((ob >> 9) & 1) << 5)); }
__host__ __device__ __forceinline__ void stage_rc(int b, int& R, int& C) { const int st = b / 1024, sb = b % 1024, swz = sb ^ (((sb >> 9) & 1) << 5); R = (st >> 1) * 16 + swz / 64; C = (st & 1) * 32 + (swz % 64) / 2; }
__host__ __device__ __forceinline__ int perm32(int rho) { const int n = rho >> 4, i = rho & 15; return 8 * (i >> 2) + 4 * n + (i & 3); }

struct Unit { int pm, pn, aux0, aux1; const char* A; const char* B; };
struct Gemm { int K, lda, ldb; };

struct StaticOrder {
    int nM, nN, nwg, G, c; const char* A0; const char* B0; size_t strideA, strideB;
    __host__ __device__ void init(int M, int N, int G_, int c_) { nM = M / BM; nN = N / BM; nwg = nM * nN; G = G_; c = c_; }
    __host__ __device__ bool next(int i, Unit& u) const {
        const long L = (long)i * G + c; if (L >= nwg) return false;
        int wgid = (int)L; { const int q = nwg / NXCD, r = nwg % NXCD, xcd = wgid % NXCD, off = wgid / NXCD; wgid = (xcd < r ? xcd * (q + 1) : r * (q + 1) + (xcd - r) * q) + off; }
        const int nig = WGM * nN, gid = wgid / nig, fm = gid * WGM, gsz = (nM - fm) < WGM ? (nM - fm) : WGM;
        u.pm = fm + ((wgid % nig) % gsz); u.pn = (wgid % nig) / gsz; u.A = A0 + (size_t)u.pm * strideA; u.B = B0 + (size_t)u.pn * strideB; return true;
    }
    __device__ __forceinline__ void a_ready(const Unit&) const {}
    __device__ __forceinline__ void done(const Unit&) const {}
};

__device__ __forceinline__ unsigned cvt_pk_bf16(float lo, float hi) { unsigned r; asm volatile("v_cvt_pk_bf16_f32 %0, %1, %2" : "=v"(r) : "v"(lo), "v"(hi)); return r; }
typedef float f32x2 __attribute__((ext_vector_type(2)));
__device__ __forceinline__ f32x2 gelu_pk(f32x2 v) {
    const f32x2 av = __builtin_elementwise_abs(v), d = av * 0.2316418882f + 1.0f;
    f32x2 t; t.x = __builtin_amdgcn_rcpf(d.x); t.y = __builtin_amdgcn_rcpf(d.y);
    f32x2 q = t * 0.5307027145f + (-0.7265760135f); q = q * t + 0.7107068705f; q = q * t + (-0.142248368f); q = q * t + 0.127414796f; q = q * t;
    const f32x2 s = (v * v) * (-0.72134752044f);
    f32x2 e; e.x = __builtin_amdgcn_exp2f(s.x); e.y = __builtin_amdgcn_exp2f(s.y);
    const f32x2 m = v * (q * e), r = v - m;
    f32x2 o; o.x = v.x < 0.f ? m.x : r.x; o.y = v.y < 0.f ? m.y : r.y; return o;
}

template <int ACT  > struct EpiBf16 {
    static constexpr bool PERM = true, AFTER_DRAIN = false; static_assert(ACT == 0 || ACT == 1, "EpiBf16: ACT is 0 (none) or 1 (gelu_pk)");
    bf16_t* O; int ldc; const float* bias; int split_cols; size_t split_stride; float scale0;
    __device__ __forceinline__ void operator()(const f32x4 (&acc)[2][2][4][2], const Unit& u, int wr, int wc, int fr, int fq) const {
        const int row0 = u.pm * BM + wr * 64 + fr; int colt = u.pn * BM; bf16_t* base = O;
        float sc = 1.f; if (split_cols) { const int t = colt / split_cols; base += (size_t)t * split_stride; colt -= t * split_cols; if (t == 0) sc = scale0; }
        const int col0 = colt + wc * 32 + 8 * fq, bcol0 = u.pn * BM + wc * 32 + 8 * fq;
        f32x4 bv[2][2];
#pragma unroll
        for (int bj = 0; bj < 2; ++bj)
#pragma unroll
            for (int n = 0; n < 2; ++n) bv[bj][n] = bias ? *(const f32x4*)(bias + bcol0 + bj * HALF + 4 * n) : (f32x4){0.f, 0.f, 0.f, 0.f};
#pragma unroll
        for (int ai = 0; ai < 2; ++ai)
#pragma unroll
            for (int m = 0; m < 4; ++m) { bf16_t* rowp = base + (size_t)(row0 + ai * HALF + m * 16) * ldc + col0;
#pragma unroll
                for (int bj = 0; bj < 2; ++bj) { f32x4 v0 = acc[ai][bj][m][0] + bv[bj][0], v1 = acc[ai][bj][m][1] + bv[bj][1];
                    if (ACT == 1) { f32x2 a = gelu_pk((f32x2){v0[0], v0[1]}), b = gelu_pk((f32x2){v0[2], v0[3]}), c = gelu_pk((f32x2){v1[0], v1[1]}), d = gelu_pk((f32x2){v1[2], v1[3]});
                        v0 = (f32x4){a.x, a.y, b.x, b.y}; v1 = (f32x4){c.x, c.y, d.x, d.y}; }
                    v0 = v0 * sc; v1 = v1 * sc; u32x4 w; w.x = cvt_pk_bf16(v0[0], v0[1]); w.y = cvt_pk_bf16(v0[2], v0[3]); w.z = cvt_pk_bf16(v1[0], v1[1]); w.w = cvt_pk_bf16(v1[2], v1[3]);
                    *(u32x4*)(rowp + bj * HALF) = w; } }
    }
};

template <class Epi, class Sched, bool ALIGN_EPI = false, bool SP2 = false, bool GATHER = false>
__device__ __forceinline__ void gemm_phase(PG8_LAS unsigned char* lds, const Gemm g, const Sched& S, const Epi& E, const PG8_LAS int* ridx = nullptr) {
    const int tid = threadIdx.x, wid = __builtin_amdgcn_readfirstlane(tid >> 6), lane = tid & 63, wr = wid >> 2, wc = wid & 3, fr = lane & 15, fq = lane >> 4;
    const int K = g.K, nt = K / BK, lda = g.lda, ldb = g.ldb;
    unsigned vA0[2], vA1[2], voffB[2];
#pragma unroll
    for (int i = 0; i < 2; ++i) { int R, C; stage_rc(tid * 16 + i * 8192, R, C); const int Rb = Epi::PERM ? ((R & ~31) + perm32(R & 31)) : R;
        vA0[i] = (unsigned)(R * lda + C) * 2u; vA1[i] = (unsigned)((R + HALF) * lda + C) * 2u; voffB[i] = (unsigned)(Rb * ldb + C) * 2u; }
#define PG8_GOFF(slot, d0, d1) do { _Pragma("unroll") for (int _i = 0; _i < 2; ++_i) { int _R, _C; stage_rc(tid * 16 + _i * 8192, _R, _C); \
        d0[_i] = (unsigned)ridx[(slot) * 256 + _R] * (unsigned)(lda * 2) + (unsigned)(_C * 2); d1[_i] = (unsigned)ridx[(slot) * 256 + HALF + _R] * (unsigned)(lda * 2) + (unsigned)(_C * 2); } } while (0)
    if constexpr (GATHER) { PG8_GOFF(0, vA0, vA1); }
    const size_t kstep = (size_t)(BK * 2);
    const size_t hstepB = (size_t)HALF * ldb * 2;
    const unsigned ldsw = (unsigned)wid * 1024u;
    const int aoff = lds_byte(wr * 64 + fr, fq * 8), boff = lds_byte(wc * 32 + fr, fq * 8);
#define PG8_SA(b, h) (((b) * 2 + (h)) * HTB)
#define PG8_SB(b, h) ((4 + (b) * 2 + (h)) * HTB)
#define PG8_STAGE(bufoff, gbase, voff) do { _Pragma("unroll") for (int _i = 0; _i < 2; ++_i) \
        __builtin_amdgcn_global_load_lds((const unsigned*)((const char*)(gbase) + (voff)[_i]), (PG8_LAS unsigned*)(lds + (bufoff) + ldsw + _i * 8192), 16, 0, 0); } while (0)
#define PG8_LDA(dst, b, h) do { _Pragma("unroll") for (int m = 0; m < 4; ++m) _Pragma("unroll") for (int k = 0; k < 2; ++k) dst[m][k] = *(const PG8_LAS bf16x8*)(lds + PG8_SA(b, h) + aoff + m * 2048 + k * 1024); } while (0)
#define PG8_LDB(dst, b, h) do { _Pragma("unroll") for (int n = 0; n < 2; ++n) _Pragma("unroll") for (int k = 0; k < 2; ++k) dst[n][k] = *(const PG8_LAS bf16x8*)(lds + PG8_SB(b, h) + boff + n * 2048 + k * 1024); } while (0)
#define PG8_MMA(ai, bj, At, Bt) do { __builtin_amdgcn_s_setprio(1); _Pragma("unroll") for (int m = 0; m < 4; ++m) _Pragma("unroll") for (int n = 0; n < 2; ++n) _Pragma("unroll") for (int k = 0; k < 2; ++k) \
        acc[ai][bj][m][n] = __builtin_amdgcn_mfma_f32_16x16x32_bf16(Bt[n][k], At[m][k], acc[ai][bj][m][n], 0, 0, 0); __builtin_amdgcn_s_setprio(0); } while (0)
#define PG8_WAIT_V(n) asm volatile("s_waitcnt vmcnt(" #n ")" ::: "memory")
#define PG8_WAIT_L(n) asm volatile("s_waitcnt lgkmcnt(" #n ")" ::: "memory")
#define PG8_BAR __builtin_amdgcn_s_barrier()
#define PG8_SCHED __builtin_amdgcn_sched_barrier(0)
    Unit cur, nxt; int ui = 0;
    if (!S.next(0, cur)) return;
    f32x4 acc[2][2][4][2];
#pragma unroll
    for (int a = 0; a < 2; ++a)
#pragma unroll
        for (int b = 0; b < 2; ++b)
#pragma unroll
            for (int m = 0; m < 4; ++m)
#pragma unroll
                for (int n = 0; n < 2; ++n) acc[a][b][m][n] = (f32x4){0.f, 0.f, 0.f, 0.f};
    bf16x8 At[4][2], B0[2][2], B1[2][2];
    const char* cA = cur.A; const char* cB = cur.B;
    S.a_ready(cur);
    if constexpr (SP2) {
        PG8_STAGE(PG8_SB(0, 0), cB, voffB); PG8_STAGE(PG8_SB(0, 1), cB + hstepB, voffB); PG8_STAGE(PG8_SA(0, 0), cA, vA0); PG8_STAGE(PG8_SA(0, 1), cA, vA1);
        if (wr == 1) PG8_BAR;
        PG8_WAIT_V(2); PG8_BAR;
        PG8_STAGE(PG8_SB(1, 0), cB + kstep, voffB); PG8_STAGE(PG8_SA(1, 0), cA + kstep, vA0); PG8_STAGE(PG8_SB(1, 1), cB + hstepB + kstep, voffB);
        PG8_WAIT_V(6); PG8_BAR;
    } else {
        PG8_STAGE(PG8_SB(0, 0), cB, voffB); PG8_STAGE(PG8_SA(0, 0), cA, vA0); PG8_STAGE(PG8_SB(0, 1), cB + hstepB, voffB); PG8_STAGE(PG8_SA(0, 1), cA, vA1);
        if (wr == 1) PG8_BAR;
        PG8_WAIT_V(4); PG8_BAR;
        PG8_STAGE(PG8_SB(1, 0), cB + kstep, voffB); PG8_STAGE(PG8_SA(1, 0), cA + kstep, vA0); PG8_STAGE(PG8_SB(1, 1), cB + hstepB + kstep, voffB);
        PG8_WAIT_V(6); PG8_BAR;
    }
    for (;;) {
        const bool has_next = S.next(ui + 1, nxt);
        const char* nA = has_next ? nxt.A : cA; const char* nB = has_next ? nxt.B : cB;
#pragma unroll 1
        for (int t = 0; t < nt; t += 2) {
            const bool last = (t == nt - 2);
            const char* a1 = cA + (size_t)(t + 1) * kstep;
            const char* a2 = last ? nA : cA + (size_t)(t + 2) * kstep; const char* b2 = last ? nB : cB + (size_t)(t + 2) * kstep;
            const char* a3 = a2 + kstep; const char* b3 = b2 + kstep;
            if (last && has_next) S.a_ready(nxt);
            unsigned sA0[2], sA1[2];
#pragma unroll
            for (int _i = 0; _i < 2; ++_i) { sA0[_i] = vA0[_i]; sA1[_i] = vA1[_i]; }
            if constexpr (GATHER) { if (last && has_next) { PG8_GOFF(ui + 1, sA0, sA1); } }
            if constexpr (SP2) {
            PG8_LDB(B0, 0, 0); PG8_LDB(B1, 0, 1); PG8_SCHED; PG8_LDA(At, 0, 0); PG8_STAGE(PG8_SA(1, 1), a1, vA1);
            PG8_WAIT_V(8); PG8_WAIT_L(0); PG8_BAR; PG8_MMA(0, 0, At, B0); PG8_MMA(0, 1, At, B1); PG8_BAR; PG8_SCHED;
            PG8_LDA(At, 0, 1); PG8_STAGE(PG8_SB(0, 0), b2, voffB); PG8_STAGE(PG8_SB(0, 1), b2 + hstepB, voffB); PG8_STAGE(PG8_SA(0, 0), a2, sA0);
            PG8_WAIT_V(8); PG8_WAIT_L(0); PG8_BAR; PG8_MMA(1, 0, At, B0); PG8_MMA(1, 1, At, B1); PG8_BAR; PG8_SCHED;
            PG8_LDB(B0, 1, 0); PG8_LDB(B1, 1, 1); PG8_SCHED; PG8_LDA(At, 1, 0); PG8_STAGE(PG8_SA(0, 1), a2, sA1);
            PG8_WAIT_V(8); PG8_WAIT_L(0); PG8_BAR; PG8_MMA(0, 0, At, B0); PG8_MMA(0, 1, At, B1); PG8_BAR; PG8_SCHED;
            PG8_LDA(At, 1, 1); PG8_STAGE(PG8_SB(1, 0), b3, voffB); PG8_STAGE(PG8_SB(1, 1), b3 + hstepB, voffB); PG8_STAGE(PG8_SA(1, 0), a3, sA0);
            PG8_WAIT_V(8); PG8_WAIT_L(0); PG8_BAR; PG8_MMA(1, 0, At, B0); PG8_MMA(1, 1, At, B1); PG8_BAR; PG8_SCHED;
            } else {
            PG8_LDB(B0, 0, 0); PG8_SCHED; PG8_LDA(At, 0, 0); PG8_STAGE(PG8_SA(1, 1), a1, vA1);
            PG8_WAIT_L(8); PG8_BAR; PG8_WAIT_L(0); PG8_MMA(0, 0, At, B0); PG8_BAR; PG8_SCHED;
            PG8_LDB(B1, 0, 1); PG8_STAGE(PG8_SB(0, 0), b2, voffB);
            PG8_BAR; PG8_WAIT_L(0); PG8_MMA(0, 1, At, B1); PG8_BAR;
            PG8_LDA(At, 0, 1); PG8_STAGE(PG8_SA(0, 0), a2, sA0);
            PG8_BAR; PG8_WAIT_L(0); PG8_MMA(1, 0, At, B0); PG8_BAR; PG8_SCHED;
            PG8_STAGE(PG8_SB(0, 1), b2 + hstepB, voffB);
            PG8_WAIT_V(6); PG8_BAR; PG8_MMA(1, 1, At, B1); PG8_BAR;
            PG8_LDB(B0, 1, 0); PG8_SCHED; PG8_LDA(At, 1, 0); PG8_STAGE(PG8_SA(0, 1), a2, sA1);
            PG8_WAIT_L(8); PG8_BAR; PG8_WAIT_L(0); PG8_MMA(0, 0, At, B0); PG8_BAR; PG8_SCHED;
            PG8_LDB(B1, 1, 1); PG8_STAGE(PG8_SB(1, 0), b3, voffB);
            PG8_BAR; PG8_WAIT_L(0); PG8_MMA(0, 1, At, B1); PG8_BAR;
            PG8_LDA(At, 1, 1); PG8_STAGE(PG8_SA(1, 0), a3, sA0);
            PG8_BAR; PG8_WAIT_L(0); PG8_MMA(1, 0, At, B0); PG8_BAR; PG8_SCHED;
            PG8_STAGE(PG8_SB(1, 1), b3 + hstepB, voffB);
            PG8_WAIT_V(6); PG8_BAR; PG8_MMA(1, 1, At, B1); PG8_BAR;
            }
        }
        if constexpr (ALIGN_EPI) { if (wr == 0) PG8_BAR; }
        if constexpr (!Epi::AFTER_DRAIN) { E(acc, cur, wr, wc, fr, fq); S.done(cur); }
        if (!has_next) break;
#pragma unroll
        for (int a = 0; a < 2; ++a)
#pragma unroll
            for (int b = 0; b < 2; ++b)
#pragma unroll
                for (int m = 0; m < 4; ++m)
#pragma unroll
                    for (int n = 0; n < 2; ++n) acc[a][b][m][n] = (f32x4){0.f, 0.f, 0.f, 0.f};
        cur = nxt; cA = nA; cB = nB; ++ui;
        if constexpr (GATHER) { PG8_GOFF(ui, vA0, vA1); }
        if constexpr (ALIGN_EPI) { if (wr == 1) PG8_BAR; }
    }
    PG8_WAIT_V(0);
    if constexpr (!ALIGN_EPI) { if (wr == 0) PG8_BAR; }
    PG8_BAR;
    if constexpr (Epi::AFTER_DRAIN) { E.fused(acc, cur, wr, wc, fr, fq, lds, wid, lane); S.done(cur); }
#undef PG8_GOFF
#undef PG8_SA
#undef PG8_SB
#undef PG8_STAGE
#undef PG8_LDA
#undef PG8_LDB
#undef PG8_MMA
#undef PG8_WAIT_V
#undef PG8_WAIT_L
#undef PG8_BAR
#undef PG8_SCHED
}
}

namespace pg8 {
struct EpiResF32 {
    static constexpr bool PERM = false, AFTER_DRAIN = false;
    const float* base; float* C; int ldc;
    __device__ __forceinline__ void operator()(const f32x4 (&acc)[2][2][4][2], const Unit& u, int wr, int wc, int fr, int fq) const {
        const int row0 = u.pm * BM + wr * 64 + fr, col0 = u.pn * BM + wc * 32 + 4 * fq;
#pragma unroll
        for (int ai = 0; ai < 2; ++ai)
#pragma unroll
            for (int m = 0; m < 4; ++m) { const size_t off = (size_t)(row0 + ai * HALF + m * 16) * ldc + col0;
#pragma unroll
                for (int bj = 0; bj < 2; ++bj)
#pragma unroll
                    for (int n = 0; n < 2; ++n) { const f32x4 b = *(const f32x4*)(base + off + bj * HALF + n * 16); *(f32x4*)(C + off + bj * HALF + n * 16) = acc[ai][bj][m][n] + b; } }
    }
};
}
namespace pg8 {
struct EpiRes2 {
    static constexpr bool PERM = false, AFTER_DRAIN = false;
    const float* base; bf16_t* Cb; int ldc;
    __device__ __forceinline__ void operator()(const f32x4 (&acc)[2][2][4][2], const Unit& u, int wr, int wc, int fr, int fq) const {
        const int row0 = u.pm * BM + wr * 64 + fr, col0 = u.pn * BM + wc * 32 + 4 * fq;
#pragma unroll
        for (int ai = 0; ai < 2; ++ai)
#pragma unroll
            for (int m = 0; m < 4; ++m) { const size_t off = (size_t)(row0 + ai * HALF + m * 16) * ldc + col0;
#pragma unroll
                for (int bj = 0; bj < 2; ++bj)
#pragma unroll
                    for (int n = 0; n < 2; ++n) { const f32x4 b = *(const f32x4*)(base + off + bj * HALF + n * 16); const f32x4 v = acc[ai][bj][m][n] + b;
                        typedef unsigned u32x2 __attribute__((ext_vector_type(2))); u32x2 w; w.x = cvt_pk_bf16(v[0], v[1]); w.y = cvt_pk_bf16(v[2], v[3]); *(u32x2*)(Cb + off + bj * HALF + n * 16) = w; } }
    }
};
struct EpiMoeH {
    static constexpr bool PERM = false, AFTER_DRAIN = false;
    bf16_t* H; const float* wlo; const float* whi; const float* rs;
    __device__ __forceinline__ void operator()(const f32x4 (&acc)[2][2][4][2], const Unit& u, int wr, int wc, int fr, int fq) const {
        const float* wsel = (u.pn >> 1) ? whi : wlo; const size_t pbase = (size_t)u.aux0 * 32768 + u.aux1;
        typedef unsigned u32x2 __attribute__((ext_vector_type(2)));
#pragma unroll
        for (int ai = 0; ai < 2; ++ai)
#pragma unroll
            for (int m = 0; m < 4; ++m) { const int r = ai * HALF + wr * 64 + m * 16 + fr; const float rsv = rs[pbase + r], wv = wsel[pbase + r];
#pragma unroll
                for (int bj = 0; bj < 2; ++bj) { const f32x4 g = acc[ai][bj][m][0] * rsv, up = acc[ai][bj][m][1] * rsv; float h[4];
#pragma unroll
                    for (int j = 0; j < 4; ++j) h[j] = g[j] / (1.f + __expf(-g[j])) * up[j] * wv;
                    const int f = (((u.pn & 1) * 8 + 4 * bj + wc) * 16) + 4 * fq;
                    u32x2 w; w.x = cvt_pk_bf16(h[0], h[1]); w.y = cvt_pk_bf16(h[2], h[3]);
                    *(u32x2*)(H + (size_t)(u.pm * BM + r) * 512 + (u.pn >> 1) * 256 + f) = w; } }
    }
};
struct EpiMoeDown {
    static constexpr bool PERM = false, AFTER_DRAIN = false;
    const bf16_t* H1; bf16_t* H2; const int* idx; const PG8_LAS int* tab;
    __device__ __forceinline__ void operator()(const f32x4 (&acc)[2][2][4][2], const Unit& u, int wr, int wc, int fr, int fq) const {
        const int cnt = tab[u.aux0]; const size_t pbase = (size_t)u.aux0 * 32768; const int col0 = u.pn * BM + wc * 32 + 4 * fq;
        typedef unsigned u32x2 __attribute__((ext_vector_type(2)));
#pragma unroll
        for (int ai = 0; ai < 2; ++ai)
#pragma unroll
            for (int m = 0; m < 4; ++m) { const int pos = u.aux1 + ai * HALF + wr * 64 + m * 16 + fr;
                if (pos < cnt) { const size_t ro = (size_t)idx[pbase + pos] * 1024 + col0;
#pragma unroll
                    for (int bj = 0; bj < 2; ++bj)
#pragma unroll
                        for (int n = 0; n < 2; ++n) { const u32x2 hv = *(const u32x2*)(H1 + ro + bj * HALF + n * 16); const f32x4 a = acc[ai][bj][m][n];
                            u32x2 w; w.x = cvt_pk_bf16(__uint_as_float(hv.x << 16) + a[0], __uint_as_float(hv.x & 0xffff0000u) + a[1]); w.y = cvt_pk_bf16(__uint_as_float(hv.y << 16) + a[2], __uint_as_float(hv.y & 0xffff0000u) + a[3]);
                            *(u32x2*)(H2 + ro + bj * HALF + n * 16) = w; } } }
    }
};
struct MoeOrder {
    const PG8_LAS int* utab; int down; const char* A0; const char* B0;
    __device__ __forceinline__ bool next(int i, Unit& u) const {
        if (i >= 8) return false;
        const int t = __builtin_amdgcn_readfirstlane(utab[i * 4]); if (t < 0) return false;
        const int pn = __builtin_amdgcn_readfirstlane(utab[i * 4 + 1]), cls = __builtin_amdgcn_readfirstlane(utab[i * 4 + 2]), pos0 = __builtin_amdgcn_readfirstlane(utab[i * 4 + 3]);
        u.pm = t; u.pn = pn; u.aux0 = cls; u.aux1 = pos0;
        const int gi = cls / 6, p = cls - gi * 6; const int ea = p < 3 ? 0 : (p < 5 ? 1 : 2), eb = p < 3 ? p + 1 : (p < 5 ? p - 1 : 3);
        if (down) { u.A = A0 + (size_t)t * 256 * 512 * 2; u.B = B0 + ((size_t)cls * 1024 + pn * 256) * 512 * 2; }
        else { const int e = gi * 4 + ((pn >> 1) ? eb : ea); u.A = A0; u.B = B0 + ((size_t)e * 512 + (pn & 1) * 256) * 1024 * 2; }
        return true;
    }
    __device__ __forceinline__ void a_ready(const Unit&) const {}
    __device__ __forceinline__ void done(const Unit&) const {}
};
}
#ifndef PG8_SP2
#define PG8_SP2 true
#endif
#ifndef PG8_ALIGN
#define PG8_ALIGN true
#endif

#define GAS __attribute__((address_space(1)))
#define LAS __attribute__((address_space(3)))
typedef unsigned short bf16;
typedef unsigned short bf16_t;
typedef unsigned v4u __attribute__((ext_vector_type(4)));
typedef float f32x4 __attribute__((ext_vector_type(4)));
typedef GAS unsigned gu32;
#define RLX_AGENT __ATOMIC_RELAXED, __HIP_MEMORY_SCOPE_AGENT
#define LDS_WAIT() asm volatile("s_waitcnt lgkmcnt(0)" ::: "memory")
#define VM_WAIT() asm volatile("s_waitcnt vmcnt(0)" ::: "memory")
__device__ __forceinline__ unsigned f2bf_u(float f) { unsigned u = __builtin_bit_cast(unsigned, f); return (u + 0x7fffu + ((u >> 16) & 1u)) >> 16; }
__device__ __forceinline__ unsigned pk2(float lo, float hi) { return f2bf_u(lo) | (f2bf_u(hi) << 16); }
__device__ __forceinline__ float bf2f(bf16_t b) { return __uint_as_float(((unsigned)b) << 16); }
__device__ __forceinline__ bf16_t f2bf(float f) { return (bf16_t)f2bf_u(f); }

#define XB_TMO      128
#define XB_XCNT(j)  (256  + 64 * (j))
#define XB_XSUB(j)  (1280 + 64 * (j))
#define XB_XGEN(j)  (2304 + 64 * (j))
#define XB_TOP      3328
#define XB_TOPGEN   3392
#define XCD_BAR_WORDS 3456
#define XB_SPIN_CAP (1u << 18)

__device__ __forceinline__ unsigned xb_ld(unsigned* p)              { return __hip_atomic_load(p, __ATOMIC_RELAXED, __HIP_MEMORY_SCOPE_AGENT); }
__device__ __forceinline__ unsigned xb_add(unsigned* p, unsigned v) { return __hip_atomic_fetch_add(p, v, __ATOMIC_RELAXED, __HIP_MEMORY_SCOPE_AGENT); }
__device__ __forceinline__ unsigned xb_xcc_id() { return (unsigned)__builtin_amdgcn_s_getreg((3 << 11) | 20) & 0xFu; }
#define XB_SPIN(cond, bar) do { unsigned _sp = 0; while (cond) { __builtin_amdgcn_s_sleep(1); \
    if ((++_sp & 255u) == 0u) { if (xb_ld(&(bar)[XB_TMO])) break; if (_sp > XB_SPIN_CAP) { atomicAdd(&(bar)[XB_TMO], 1u); break; } } } } while (0)

struct XcdBarrier {
    unsigned* bar; unsigned x;
    volatile LAS unsigned* st;
};

__device__ __forceinline__ XcdBarrier xcd_barrier_post(unsigned* bar, volatile LAS unsigned* st) {
    XcdBarrier b; b.bar = bar; b.x = xb_xcc_id(); b.st = st;
    if (threadIdx.x == 0) (void)xb_add(&bar[XB_XCNT(b.x)], 1u);
    return b;
}
__device__ __forceinline__ void xcd_barrier_complete(unsigned* bar, unsigned x, unsigned& nloc, unsigned& nx) {
    const unsigned G = gridDim.x * gridDim.y * gridDim.z;
    unsigned sum, cnt, mine, sp = 0u;
    for (;;) {
        sum = 0u; cnt = 0u; mine = 0u;
#pragma unroll
        for (unsigned j = 0; j < 16; ++j) { const unsigned c = xb_ld(&bar[XB_XCNT(j)]); sum += c; cnt += (c > 0u) ? 1u : 0u; mine = (j == x) ? c : mine; }
        if (sum == G) break;
        __builtin_amdgcn_s_sleep(1);
        if ((++sp & 255u) == 0u) { if (xb_ld(&bar[XB_TMO])) break; if (sp > XB_SPIN_CAP) { atomicAdd(&bar[XB_TMO], 1u); break; } }
    }
    nloc = mine > 0u ? mine : 1u; nx = cnt > 0u ? cnt : 1u;
}

__device__ __forceinline__ void xcd_barrier(const XcdBarrier& b) {
    asm volatile("s_waitcnt vmcnt(0)" ::: "memory");
    __syncthreads();
    if (threadIdx.x == 0) {
        unsigned* bar = b.bar;
        __builtin_amdgcn_s_waitcnt(0);
        unsigned nloc = b.st[0], nx = b.st[1];
        if (nloc == 0u) { xcd_barrier_complete(bar, b.x, nloc, nx); b.st[0] = nloc; b.st[1] = nx; }
        const unsigned old = xb_add(&bar[XB_XSUB(b.x)], 1u);
        const unsigned gen = old / nloc;
        if (old + 1u == (gen + 1u) * nloc) {
            __builtin_amdgcn_fence(__ATOMIC_RELEASE, "agent");
            asm volatile("s_waitcnt vmcnt(0)" ::: "memory");
            const unsigned og = xb_add(&bar[XB_TOP], 1u);
            const unsigned tg = og / nx;
            if (og + 1u == (tg + 1u) * nx) xb_add(&bar[XB_TOPGEN], 1u);
            else XB_SPIN(xb_ld(&bar[XB_TOPGEN]) == tg, bar);
            __builtin_amdgcn_fence(__ATOMIC_ACQUIRE, "agent");
            xb_add(&bar[XB_XGEN(b.x)], 1u);
            asm volatile("s_waitcnt vmcnt(0)" ::: "memory");
        } else {
            XB_SPIN(xb_ld(&bar[XB_XGEN(b.x)]) == gen, bar);
            __builtin_amdgcn_fence(__ATOMIC_ACQUIRE, "agent");
            asm volatile("s_waitcnt vmcnt(0)" ::: "memory");
        }
    }
    __syncthreads();
}

namespace pg8 {
struct S5Order {
    int G, c; const char* A0; const char* B0; size_t strideAg, strideBg;
    __device__ __forceinline__ bool next(int i, Unit& u) const {
        const int L = i * G + c; if (L >= 128) return false;
        const int g = L >> 3, rt = L & 7; u.pm = L; u.pn = 0; u.aux0 = g; u.aux1 = rt;
        u.A = A0 + (size_t)g * strideAg + (size_t)rt * 256 * 384 * 2; u.B = B0 + (size_t)g * strideBg; return true;
    }
    __device__ __forceinline__ void a_ready(const Unit&) const {}
    __device__ __forceinline__ void done(const Unit&) const {}
};
struct EpiS5Loc {
    static constexpr bool PERM = false, AFTER_DRAIN = false;
    float* loc;
    __device__ __forceinline__ void operator()(const f32x4 (&acc)[2][2][4][2], const Unit& u, int wr, int wc, int fr, int fq) const {
        float* base = loc + ((size_t)u.aux0 * 2048 + u.aux1 * 256) * 128; const int col0 = wc * 32 + 4 * fq;
#pragma unroll
        for (int ai = 0; ai < 2; ++ai)
#pragma unroll
            for (int m = 0; m < 4; ++m) { float* rowp = base + (size_t)(ai * HALF + wr * 64 + m * 16 + fr) * 128 + col0;
#pragma unroll
                for (int n = 0; n < 2; ++n) *(f32x4*)(rowp + n * 16) = acc[ai][0][m][n]; }
    }
};
__device__ __forceinline__ float gelu_tanh_f(float x) { const float z = 1.5957691216057308f * (x + 0.044715f * x * x * x); return x - x * __builtin_amdgcn_rcpf(1.f + __expf(z)); }
struct EpiS5Y {
    static constexpr bool PERM = true, AFTER_DRAIN = false;
    bf16_t* Y;
    __device__ __forceinline__ void operator()(const f32x4 (&acc)[2][2][4][2], const Unit& u, int wr, int wc, int fr, int fq) const {
        const int g = u.aux0, rt = u.aux1;
#pragma unroll
        for (int ai = 0; ai < 2; ++ai)
#pragma unroll
            for (int m = 0; m < 4; ++m) { const int r = rt * 256 + ai * HALF + wr * 64 + m * 16 + fr; const size_t tok0 = (size_t)(r >> 8) * 4096 + (size_t)(r & 255) * 16;
#pragma unroll
                for (int bj = 0; bj < 2; ++bj) { const int n0 = bj * HALF + wc * 32 + 8 * fq; const f32x4 v0 = acc[ai][bj][m][0], v1 = acc[ai][bj][m][1];
                    u32x4 w; w.x = cvt_pk_bf16(gelu_tanh_f(v0[0]), gelu_tanh_f(v0[1])); w.y = cvt_pk_bf16(gelu_tanh_f(v0[2]), gelu_tanh_f(v0[3])); w.z = cvt_pk_bf16(gelu_tanh_f(v1[0]), gelu_tanh_f(v1[1])); w.w = cvt_pk_bf16(gelu_tanh_f(v1[2]), gelu_tanh_f(v1[3]));
                    *(u32x4*)(Y + (tok0 + (n0 >> 4)) * 256 + g * 16 + (n0 & 15)) = w; } }
    }
};
struct EpiGlu {
    static constexpr bool PERM = true, AFTER_DRAIN = false;
    const bf16_t* Y; bf16_t* O; int ldo;
    __device__ __forceinline__ void operator()(const f32x4 (&acc)[2][2][4][2], const Unit& u, int wr, int wc, int fr, int fq) const {
        const int row0 = u.pm * BM + wr * 64 + fr, col0 = wc * 32 + 8 * fq;
#pragma unroll
        for (int ai = 0; ai < 2; ++ai)
#pragma unroll
            for (int m = 0; m < 4; ++m) { const size_t row = (size_t)(row0 + ai * HALF + m * 16);
#pragma unroll
                for (int bj = 0; bj < 2; ++bj) { const u32x4 yv = *(const u32x4*)(Y + row * 256 + col0 + bj * HALF); const f32x4 v0 = acc[ai][bj][m][0], v1 = acc[ai][bj][m][1]; float o[8];
#pragma unroll
                    for (int q = 0; q < 4; ++q) { const float ylo = __uint_as_float(yv[q] << 16), yhi = __uint_as_float(yv[q] & 0xffff0000u); const float a0 = q < 2 ? v0[2 * q] : v1[2 * q - 4], a1 = q < 2 ? v0[2 * q + 1] : v1[2 * q - 3];
                        o[2 * q] = ylo * __builtin_amdgcn_rcpf(1.f + __expf(-a0)); o[2 * q + 1] = yhi * __builtin_amdgcn_rcpf(1.f + __expf(-a1)); }
                    u32x4 w; w.x = cvt_pk_bf16(o[0], o[1]); w.y = cvt_pk_bf16(o[2], o[3]); w.z = cvt_pk_bf16(o[4], o[5]); w.w = cvt_pk_bf16(o[6], o[7]);
                    *(u32x4*)(O + row * ldo + col0 + bj * HALF) = w; } }
    }
};
}

namespace pg8 {
struct EpiZ {
    static constexpr bool PERM = true, AFTER_DRAIN = false;
    bf16_t* Z; int ldz; bf16_t* A2; const float* CS;
    __device__ __forceinline__ void operator()(const f32x4 (&acc)[2][2][4][2], const Unit& u, int wr, int wc, int fr, int fq) const {
        const int row0 = u.pm * BM + wr * 64 + fr;
        if (u.pn == 0) {
#pragma unroll
            for (int ai = 0; ai < 2; ++ai)
#pragma unroll
                for (int m = 0; m < 4; ++m) { const int row = row0 + ai * HALF + m * 16, b = row >> 12, sq = row & 4095;
#pragma unroll
                    for (int bj = 0; bj < 2; ++bj) { const int ch = bj * HALF + wc * 32 + 8 * fq; const f32x4 v0 = acc[ai][bj][m][0], v1 = acc[ai][bj][m][1];
                        u32x4 w; w.x = cvt_pk_bf16(v0[0], v0[1]); w.y = cvt_pk_bf16(v0[2], v0[3]); w.z = cvt_pk_bf16(v1[0], v1[1]); w.w = cvt_pk_bf16(v1[2], v1[3]);
                        *(u32x4*)(A2 + ((size_t)(ch >> 4) * 2048 + b * 256 + (sq >> 4)) * 384 + 128 + (sq & 15) * 16 + (ch & 15)) = w; } }
        } else if (u.pn <= 6) {
            const int i0 = 16 * wc + 4 * fq;
#pragma unroll
            for (int ai = 0; ai < 2; ++ai)
#pragma unroll
                for (int m = 0; m < 4; ++m) { const int row = row0 + ai * HALF + m * 16, sq = row & 4095;
                    const f32x4 c0 = *(const f32x4*)(CS + ((size_t)sq * 64 + i0) * 2), c1 = *(const f32x4*)(CS + ((size_t)sq * 64 + i0) * 2 + 4);
                    bf16_t* rowp = Z + (size_t)row * ldz + u.pn * BM + wc * 32 + 8 * fq;
#pragma unroll
                    for (int bj = 0; bj < 2; ++bj) { const f32x4 v0 = acc[ai][bj][m][0], v1 = acc[ai][bj][m][1];
                        u32x4 w; w.x = cvt_pk_bf16(v0[0] * c0[0] - v0[1] * c0[1], v0[1] * c0[0] + v0[0] * c0[1]); w.y = cvt_pk_bf16(v0[2] * c0[2] - v0[3] * c0[3], v0[3] * c0[2] + v0[2] * c0[3]);
                        w.z = cvt_pk_bf16(v1[0] * c1[0] - v1[1] * c1[1], v1[1] * c1[0] + v1[0] * c1[1]); w.w = cvt_pk_bf16(v1[2] * c1[2] - v1[3] * c1[3], v1[3] * c1[2] + v1[2] * c1[3]);
                        *(u32x4*)(rowp + bj * HALF) = w; } }
        } else {
#pragma unroll
            for (int ai = 0; ai < 2; ++ai)
#pragma unroll
                for (int m = 0; m < 4; ++m) { bf16_t* rowp = Z + (size_t)(row0 + ai * HALF + m * 16) * ldz + u.pn * BM + wc * 32 + 8 * fq;
#pragma unroll
                    for (int bj = 0; bj < 2; ++bj) { const f32x4 v0 = acc[ai][bj][m][0], v1 = acc[ai][bj][m][1];
                        u32x4 w; w.x = cvt_pk_bf16(v0[0], v0[1]); w.y = cvt_pk_bf16(v0[2], v0[3]); w.z = cvt_pk_bf16(v1[0], v1[1]); w.w = cvt_pk_bf16(v1[2], v1[3]);
                        *(u32x4*)(rowp + bj * HALF) = w; } }
        }
    }
};
}

namespace ret {
using bf16x8 = __attribute__((ext_vector_type(8))) short;
using s16x4  = __attribute__((ext_vector_type(4))) short;
using f32x16 = __attribute__((ext_vector_type(16))) float;
using u32x4  = __attribute__((ext_vector_type(4))) unsigned;
#define RET_KSWZ(row, colB) ((row) * 256 + ((colB) ^ (((row) & 7) << 4)))
#define RET_SBAR() __builtin_amdgcn_sched_barrier(0)
__device__ __forceinline__ int crow(int r, int hi) { return (r & 3) + 8 * (r >> 2) + 4 * hi; }
__device__ __forceinline__ unsigned cvtpk(float lo, float hi) { unsigned r; asm volatile("v_cvt_pk_bf16_f32 %0, %1, %2" : "=v"(r) : "v"(lo), "v"(hi)); return r; }
__device__ __forceinline__ int v_st(int k, int c) { const int kk = (k & ~0xC) | ((k & 4) << 1) | ((k & 8) >> 1); return ((kk >> 3) * 4 + (c >> 5)) * 512 + ((kk & 7) * 32 + (c & 31)) * 2; }
__device__ __forceinline__ int v_rd_base(int lane) { return ((lane & 3) << 3) | (((lane >> 2) & 3) << 6) | (((lane >> 4) & 1) << 5) | (((lane >> 5) & 1) << 8); }
constexpr int v_rd_off(int d0, int ks, int half) { return d0 * 512 + ks * 4096 + half * 2048; }
template <int OFF> __device__ __forceinline__ s16x4 tr_read(int vb) { s16x4 r; asm volatile("ds_read_b64_tr_b16 %0, %1 offset:%2" : "=&v"(r) : "v"(vb), "i"(OFF) : "memory"); return r; }
#define RET_PK(L, H) (bf16x8){L[0], L[1], L[2], L[3], H[0], H[1], H[2], H[3]}
__device__ __forceinline__ void qkt(f32x16& p0, f32x16& p1, const LAS unsigned char* Ks, const bf16x8 (&qr)[8], int r32, int hi) {
    p0 = f32x16{}; p1 = f32x16{};
#pragma unroll
    for (int d0 = 0; d0 < 8; ++d0) { const int cb = (d0 * 16 + hi * 8) * 2;
        const bf16x8 b0 = *(const LAS bf16x8*)(Ks + RET_KSWZ(r32, cb));
        const bf16x8 b1 = *(const LAS bf16x8*)(Ks + RET_KSWZ(32 + r32, cb));
        p0 = __builtin_amdgcn_mfma_f32_32x32x16_bf16(b0, qr[d0], p0, 0, 0, 0);
        p1 = __builtin_amdgcn_mfma_f32_32x32x16_bf16(b1, qr[d0], p1, 0, 0, 0); }
}
template <int D0> __device__ __forceinline__ void pv_one(f32x16& od, int vb, bf16x8 pa0, bf16x8 pa1, bf16x8 pa2, bf16x8 pa3) {
    const s16x4 l0 = tr_read<v_rd_off(D0, 0, 0)>(vb), h0 = tr_read<v_rd_off(D0, 0, 1)>(vb), l1 = tr_read<v_rd_off(D0, 1, 0)>(vb), h1 = tr_read<v_rd_off(D0, 1, 1)>(vb);
    const s16x4 l2 = tr_read<v_rd_off(D0, 2, 0)>(vb), h2 = tr_read<v_rd_off(D0, 2, 1)>(vb), l3 = tr_read<v_rd_off(D0, 3, 0)>(vb), h3 = tr_read<v_rd_off(D0, 3, 1)>(vb);
    asm volatile("s_waitcnt lgkmcnt(0)" ::: "memory"); RET_SBAR();
    od = __builtin_amdgcn_mfma_f32_32x32x16_bf16(pa0, RET_PK(l0, h0), od, 0, 0, 0);
    od = __builtin_amdgcn_mfma_f32_32x32x16_bf16(pa1, RET_PK(l1, h1), od, 0, 0, 0);
    od = __builtin_amdgcn_mfma_f32_32x32x16_bf16(pa2, RET_PK(l2, h2), od, 0, 0, 0);
    od = __builtin_amdgcn_mfma_f32_32x32x16_bf16(pa3, RET_PK(l3, h3), od, 0, 0, 0);
}
__device__ __forceinline__ float gamma_log2(int h) { return log2f(1.0f - exp2f(-5.0f - (float)h)); }

__device__ __forceinline__ void loc_item(LAS unsigned char* lds, const bf16_t* Zk, const bf16_t* Zv, int ldz, float lg, float* KVo, int tid, int wave, int lane) {
    const int sr = tid >> 4, sc = (tid & 15) * 8, hi = lane >> 5, r32 = lane & 31;
#pragma unroll
    for (int m = 0; m < 4; ++m)
#pragma unroll
        for (int half = 0; half < 2; ++half) { const int key = 32 * half + sr, j = 64 * m + key;
            const bf16x8 kv = *(const bf16x8*)(Zk + (size_t)j * ldz + sc), vv = *(const bf16x8*)(Zv + (size_t)j * ldz + sc);
            const float dc = exp2f(lg * (float)(255 - j)); u32x4 w;
#pragma unroll
            for (int q = 0; q < 4; ++q) w[q] = cvtpk(__uint_as_float(((unsigned)(unsigned short)kv[2 * q]) << 16) * dc, __uint_as_float(((unsigned)(unsigned short)kv[2 * q + 1]) << 16) * dc);
            *(LAS u32x4*)(lds + m * 16384 + v_st(key, sc)) = w;
            *(LAS bf16x8*)(lds + 65536 + m * 16384 + v_st(key, sc)) = vv; }
    __syncthreads();
    const int eb = wave >> 1, db0 = 2 * (wave & 1);
    const int kb = (int)(uintptr_t)lds + v_rd_base(lane), vb = kb + 65536;
    f32x16 acc0 = f32x16{}, acc1 = f32x16{};
#define RET_LOC_STEP(M, KS) do { \
        const s16x4 al = tr_read<(M) * 16384 + 0 * 512 + (KS) * 4096>(vb + eb * 512), ah = tr_read<(M) * 16384 + 0 * 512 + (KS) * 4096 + 2048>(vb + eb * 512); \
        const s16x4 bl0 = tr_read<(M) * 16384 + (KS) * 4096>(kb + db0 * 512), bh0 = tr_read<(M) * 16384 + (KS) * 4096 + 2048>(kb + db0 * 512); \
        const s16x4 bl1 = tr_read<(M) * 16384 + 512 + (KS) * 4096>(kb + db0 * 512), bh1 = tr_read<(M) * 16384 + 512 + (KS) * 4096 + 2048>(kb + db0 * 512); \
        asm volatile("s_waitcnt lgkmcnt(0)" ::: "memory"); RET_SBAR(); \
        acc0 = __builtin_amdgcn_mfma_f32_32x32x16_bf16(RET_PK(al, ah), RET_PK(bl0, bh0), acc0, 0, 0, 0); \
        acc1 = __builtin_amdgcn_mfma_f32_32x32x16_bf16(RET_PK(al, ah), RET_PK(bl1, bh1), acc1, 0, 0, 0); } while (0)
#define RET_LOC_TILE(M) do { RET_LOC_STEP(M, 0); RET_LOC_STEP(M, 1); RET_LOC_STEP(M, 2); RET_LOC_STEP(M, 3); } while (0)
    RET_LOC_TILE(0); RET_LOC_TILE(1); RET_LOC_TILE(2); RET_LOC_TILE(3);
#undef RET_LOC_TILE
#undef RET_LOC_STEP
#pragma unroll
    for (int r = 0; r < 16; ++r) { const int e = 32 * eb + crow(r, hi); KVo[(size_t)e * 128 + 32 * db0 + r32] = acc0[r]; KVo[(size_t)e * 128 + 32 * (db0 + 1) + r32] = acc1[r]; }
    __syncthreads();
}

__device__ __forceinline__ void out_item(LAS unsigned char* lds, const bf16_t* Zq, const bf16_t* Zk, const bf16_t* Zv, const bf16_t* Zg, int ldz, const bf16_t* Rt, float lg, bf16_t* out, int ldo, int tid, int wave, int lane) {
    const int sr = tid >> 4, sc = (tid & 15) * 8, hi = lane >> 5, r32 = lane & 31;
#pragma unroll
    for (int m = 0; m < 4; ++m)
#pragma unroll
        for (int half = 0; half < 2; ++half) { const int key = 32 * half + sr, j = 64 * m + key;
            const bf16x8 kv = *(const bf16x8*)(Zk + (size_t)j * ldz + sc), vv = *(const bf16x8*)(Zv + (size_t)j * ldz + sc);
            *(LAS bf16x8*)(lds + m * 16384 + RET_KSWZ(key, sc * 2)) = kv;
            *(LAS bf16x8*)(lds + 65536 + m * 16384 + v_st(key, sc)) = vv; }
    const int rb = wave < 4 ? wave : ((wave & 3) < 2 ? 6 + (wave & 3) : 2 + (wave & 3)), n = rb >> 1;
    bf16x8 qr[8];
    { const bf16_t* qp = Zq + (size_t)(32 * rb + r32) * ldz + hi * 8;
#pragma unroll
      for (int d0 = 0; d0 < 8; ++d0) qr[d0] = *(const bf16x8*)(qp + d0 * 16); }
    f32x16 o[4];
#pragma unroll
    for (int ebk = 0; ebk < 4; ++ebk) { o[ebk] = f32x16{}; const bf16_t* rp = Rt + (size_t)(32 * ebk + r32) * 128 + hi * 8;
#pragma unroll
        for (int d0 = 0; d0 < 8; ++d0) { const bf16x8 rf = *(const bf16x8*)(rp + d0 * 16); o[ebk] = __builtin_amdgcn_mfma_f32_32x32x16_bf16(qr[d0], rf, o[ebk], 0, 0, 0); } }
#pragma unroll
    for (int r = 0; r < 16; ++r) { const float f = exp2f(lg * (float)(32 * rb + crow(r, hi) + 1));
#pragma unroll
        for (int ebk = 0; ebk < 4; ++ebk) o[ebk][r] *= f; }
    float ta[4], tb[4];
#pragma unroll
    for (int q = 0; q < 4; ++q) { ta[q] = exp2f(-lg * (float)q); tb[q] = exp2f(-lg * (float)(8 * q + 4 * hi)); }
    const float T32 = exp2f(-lg * 32.f);
    const int iq = 32 * rb + r32;
    const int vb = (int)(uintptr_t)lds + 65536 + v_rd_base(lane);
    __syncthreads();
    for (int m = 0; m <= n; ++m) {
        f32x16 p0, p1;
        qkt(p0, p1, lds + m * 16384, qr, r32, hi);
        if (m < n) { const float base = exp2f(lg * (float)(iq - 64 * m)); float b0[4], b1[4];
#pragma unroll
            for (int q = 0; q < 4; ++q) { b0[q] = base * tb[q]; b1[q] = b0[q] * T32; }
#pragma unroll
            for (int r = 0; r < 16; ++r) { p0[r] *= b0[r >> 2] * ta[r & 3]; p1[r] *= b1[r >> 2] * ta[r & 3]; } }
        else {
#pragma unroll
            for (int r = 0; r < 16; ++r) { const int d0_ = iq - 64 * m - crow(r, hi), d1_ = d0_ - 32;
                p0[r] *= exp2f(lg * (float)(d0_ < 0 ? -d0_ : d0_)); p1[r] *= exp2f(lg * (float)(d1_ < 0 ? -d1_ : d1_)); } }
        bf16x8 pa0, pa1, pa2, pa3;
#define RET_PK4(P, BASE, OUT) do { const unsigned a0 = cvtpk(P[BASE + 0], P[BASE + 1]), a1 = cvtpk(P[BASE + 2], P[BASE + 3]); \
        const unsigned b0 = cvtpk(P[BASE + 4], P[BASE + 5]), b1 = cvtpk(P[BASE + 6], P[BASE + 7]); \
        auto r0 = __builtin_amdgcn_permlane32_swap(a0, b0, false, false); auto r1 = __builtin_amdgcn_permlane32_swap(a1, b1, false, false); \
        u32x4 w = {r0[0], r1[0], r0[1], r1[1]}; OUT = *reinterpret_cast<bf16x8*>(&w); } while (0)
        RET_PK4(p0, 0, pa0); RET_PK4(p0, 8, pa1); RET_PK4(p1, 0, pa2); RET_PK4(p1, 8, pa3);
#undef RET_PK4
        const int vbm = vb + m * 16384;
        pv_one<0>(o[0], vbm, pa0, pa1, pa2, pa3); pv_one<1>(o[1], vbm, pa0, pa1, pa2, pa3); pv_one<2>(o[2], vbm, pa0, pa1, pa2, pa3); pv_one<3>(o[3], vbm, pa0, pa1, pa2, pa3);
    }
    int rbase = 32 * rb + 4 * hi; asm volatile("" : "+v"(rbase));
#pragma unroll
    for (int r = 0; r < 16; ++r) {
        float s = (o[0][r] + o[1][r]) + (o[2][r] + o[3][r]);
#pragma unroll
        for (int off = 1; off < 32; off <<= 1) s += __shfl_xor(s, off);
        const float mu = s * (1.f / 128.f);
        float v = 0.f;
#pragma unroll
        for (int ebk = 0; ebk < 4; ++ebk) { const float dl = o[ebk][r] - mu; v += dl * dl; }
#pragma unroll
        for (int off = 1; off < 32; off <<= 1) v += __shfl_xor(v, off);
        const float rs = rsqrtf(v * (1.f / 128.f) + EPS);
        const size_t row = (size_t)(rbase + (r & 3) + 8 * (r >> 2));
#pragma unroll
        for (int ebk = 0; ebk < 4; ++ebk) { const float gt = bf2f(Zg[row * ldz + 32 * ebk + r32]); const float sl = gt / (1.f + __expf(-gt)); out[row * ldo + 32 * ebk + r32] = f2bf(sl * (o[ebk][r] - mu) * rs); }
    }
    __syncthreads();
}
}

constexpr int NWAVES = 8;
constexpr int RING_BYTES = 131072, LDSCTL_OFF = RING_BYTES, MISC_OFF = LDSCTL_OFF + 320, TAB_OFF = LDSCTL_OFF + 512, RIDX_OFF = LDSCTL_OFF + 1024, MAXU = 8, LDS_BYTES = 147456;
static_assert(RIDX_OFF + MAXU * 1024 <= LDS_BYTES, "LDS map");
constexpr int CW_BAR = 4096;
constexpr int CW_CNT = 1024;
constexpr size_t CTL_BYTES = 1u << 20;

__device__ __forceinline__ float sel4(float a, float b, float c, float d, int i) { const float x = (i & 1) ? b : a, y = (i & 1) ? d : c; return (i & 2) ? y : x; }
__device__ __forceinline__ float wave_sum(float v) {
    v += __builtin_bit_cast(float, __builtin_amdgcn_update_dpp(0, __builtin_bit_cast(int, v), 0x128, 0xf, 0xf, false));
    v += __builtin_bit_cast(float, __builtin_amdgcn_update_dpp(0, __builtin_bit_cast(int, v), 0x124, 0xf, 0xf, false));
    v += __builtin_bit_cast(float, __builtin_amdgcn_update_dpp(0, __builtin_bit_cast(int, v), 0x122, 0xf, 0xf, false));
    v += __builtin_bit_cast(float, __builtin_amdgcn_update_dpp(0, __builtin_bit_cast(int, v), 0x121, 0xf, 0xf, false));
    { auto r = __builtin_amdgcn_permlane16_swap(__float_as_uint(v), __float_as_uint(v), false, false); v = __uint_as_float(r[0]) + __uint_as_float(r[1]); }
    { auto r = __builtin_amdgcn_permlane32_swap(__float_as_uint(v), __float_as_uint(v), false, false); v = __uint_as_float(r[0]) + __uint_as_float(r[1]); }
    return v;
}
template <class SrcF> __device__ __forceinline__ void tr_item(SrcF src, bf16* dst, int ldd, LAS float* scr, int lane) {
#pragma unroll 8
    for (int i = 0; i < 32; ++i) { const int kk = 2 * i + (lane >> 5); scr[kk * 33 + (lane & 31)] = src(kk, lane & 31); }
    LDS_WAIT(); asm volatile("" ::: "memory");
    const int c = lane & 7;
#pragma unroll
    for (int j = 0; j < 4; ++j) { const int n = (lane >> 3) + 8 * j; const LAS float* s = scr + (8 * c) * 33 + n;
        v4u o; o.x = pk2(s[0 * 33], s[1 * 33]); o.y = pk2(s[2 * 33], s[3 * 33]); o.z = pk2(s[4 * 33], s[5 * 33]); o.w = pk2(s[6 * 33], s[7 * 33]);
        *(GAS v4u*)(dst + (size_t)n * ldd + 8 * c) = o; }
    LDS_WAIT(); asm volatile("" ::: "memory");
}
__device__ __forceinline__ void rms_row_to_bf16(const float* xrow, bf16* orow, int lane) {
    const GAS f32x4* xr = (const GAS f32x4*)xrow + lane;
    f32x4 v[4]; float s = 0.f;
#pragma unroll
    for (int j = 0; j < 4; ++j) { v[j] = xr[64 * j]; s += (v[j].x * v[j].x + v[j].y * v[j].y) + (v[j].z * v[j].z + v[j].w * v[j].w); }
    const float rstd = rsqrtf(wave_sum(s) * (1.f / DM) + EPS);
    GAS unsigned long long* o8 = (GAS unsigned long long*)orow + lane;
#pragma unroll
    for (int j = 0; j < 4; ++j) o8[64 * j] = (unsigned long long)pk2(v[j].x * rstd, v[j].y * rstd) | ((unsigned long long)pk2(v[j].z * rstd, v[j].w * rstd) << 32);
}

typedef float f32x2v __attribute__((ext_vector_type(2)));
struct S5Tabs { f32x2v* lam1; f32x2v* lam16; f32x2v* bbg; };
__device__ __forceinline__ void s5_prep_item(int g, int i, const float* lre, const float* lim, const float* ldt, const float* bre, const float* bim, const float* cre, const float* cim, const float* dsk,
                                             bf16_t* W1t, bf16_t* W2t, S5Tabs T, LAS unsigned char* scr, int tid) {
    LAS f32x2v* pwl = (LAS f32x2v*)scr;
    LAS f32x2v* bbl = (LAS f32x2v*)(scr + 17 * 64 * 8);
    LAS f32x2v* cl = (LAS f32x2v*)(scr + 17 * 64 * 8 + 8192);
    if (tid < 64) { const int p = tid;
        const float re = lre[g * 64 + p], im = lim[g * 64 + p], dt = expf(ldt[g]);
        const float a = re * dt; const double th_d = (double)im * (double)dt;
        const float th = (float)(th_d - 6.283185307179586476925 * rint(th_d * 0.15915494309189533577));
        const float ea = expf(a), em1 = expm1f(a); float sn, cs; sincosf(th, &sn, &cs); const float sh = sinf(0.5f * th);
        const float lbr = ea * cs, lbi = ea * sn, mr = em1 * cs - 2.f * sh * sh, mi = ea * sn, den = re * re + im * im;
        const float fr = (mr * re + mi * im) / den, fi = (mi * re - mr * im) / den;
        for (int h = 0; h < 16; ++h) { const float br = bre[(g * 64 + p) * 16 + h], bi = bim[(g * 64 + p) * 16 + h]; const f32x2v v = (f32x2v){fr * br - fi * bi, fr * bi + fi * br}; bbl[p * 16 + h] = v; if (i == 0) T.bbg[(g * 64 + p) * 16 + h] = v; }
        float xr = 1.f, xi = 0.f;
        for (int d = 0; d <= 16; ++d) { pwl[d * 64 + p] = (f32x2v){xr, xi}; const float nr = xr * lbr - xi * lbi, ni = xr * lbi + xi * lbr; xr = nr; xi = ni; }
        if (i == 0) { T.lam1[g * 64 + p] = (f32x2v){lbr, lbi}; T.lam16[g * 64 + p] = pwl[16 * 64 + p]; }
    }
    for (int e = tid; e < 1024; e += NWAVES * 64) cl[e] = (f32x2v){cre[g * 1024 + e], cim[g * 1024 + e]};
    __syncthreads();
    bf16_t* w2 = W2t + (size_t)g * 256 * 384; bf16_t* w1 = W1t + (size_t)g * 256 * 256;
    for (int e = tid; e < 1024; e += NWAVES * 64) { const int h = e >> 6, p = e & 63; const f32x2v c = cl[e], w = pwl[(i + 1) * 64 + p];
        w2[(size_t)(i * 16 + h) * 384 + p] = f2bf(c.x * w.x - c.y * w.y); w2[(size_t)(i * 16 + h) * 384 + 64 + p] = f2bf(-(c.x * w.y + c.y * w.x)); }
    LAS float* kdl = (LAS float*)(scr + 17 * 64 * 8 + 8192 + 8192);
    if (tid < 256) { const int h = tid >> 4, h2 = tid & 15; float v = 0.f;
        for (int p = 0; p < 64; ++p) { const f32x2v c = cl[h * 64 + p], w = pwl[i * 64 + p], b = bbl[p * 16 + h2]; const float tr = c.x * w.x - c.y * w.y, ti = c.x * w.y + c.y * w.x; v += tr * b.x - ti * b.y; }
        if (i == 0 && h == h2) v += dsk[g * 16 + h];
        kdl[tid] = v; }
    __syncthreads();
    for (int e = tid; e < (16 - i) * 256; e += NWAVES * 64) { const int j = e >> 8, h = (e >> 4) & 15, h2 = e & 15; w2[(size_t)((i + j) * 16 + h) * 384 + 128 + j * 16 + h2] = f2bf(kdl[h * 16 + h2]); }
    for (int e = tid; e < (15 - i) * 256; e += NWAVES * 64) { const int j = i + 1 + (e >> 8), h = (e >> 4) & 15, h2 = e & 15; w2[(size_t)(i * 16 + h) * 384 + 128 + j * 16 + h2] = 0; }
    for (int e = tid; e < 1024; e += NWAVES * 64) { const int p = e >> 4, h2 = e & 15; const f32x2v w = pwl[(15 - i) * 64 + p], b = bbl[p * 16 + h2];
        w1[(size_t)p * 256 + i * 16 + h2] = f2bf(w.x * b.x - w.y * b.y); w1[(size_t)(64 + p) * 256 + i * 16 + h2] = f2bf(w.x * b.y + w.y * b.x); }
    for (int e = tid; e < 2048; e += NWAVES * 64) w1[(size_t)(128 + (e >> 4)) * 256 + i * 16 + (e & 15)] = 0;
    __syncthreads();
}
template <class UM> __device__ __forceinline__ void s5_scan_item(int b, int g, const float* loc, bf16_t* A2, S5Tabs T, UM umeta, LAS unsigned char* scr, int tid) {
    LAS f32x2v* tot = (LAS f32x2v*)scr;
    const int p = tid & 63, sg = tid >> 6;
    const f32x2v l1 = T.lam1[g * 64 + p], l16 = T.lam16[g * 64 + p];
    float x0r = 0.f, x0i = 0.f;
    for (int j = 0; j < NMETA; ++j) { float sr = 0.f, si = 0.f;
#pragma unroll
        for (int h = 0; h < 16; ++h) { const f32x2v bv = T.bbg[(g * 64 + p) * 16 + h]; const float uv = umeta(j, h); sr = fmaf(bv.x, uv, sr); si = fmaf(bv.y, uv, si); }
        const float nr = l1.x * x0r - l1.y * x0i + sr, ni = l1.x * x0i + l1.y * x0r + si; x0r = nr; x0i = ni; }
    const float* lp = loc + ((size_t)g * 2048 + b * 256 + sg * 32) * 128 + p;
    float lr[32], li[32];
#pragma unroll
    for (int q = 0; q < 32; ++q) { lr[q] = lp[(size_t)q * 128]; li[q] = lp[(size_t)q * 128 + 64]; }
    float xr = 0.f, xi = 0.f;
#pragma unroll
    for (int q = 0; q < 32; ++q) { const float nr = l16.x * xr - l16.y * xi + lr[q], ni = l16.x * xi + l16.y * xr + li[q]; xr = nr; xi = ni; lr[q] = xr; li[q] = xi; }
    tot[sg * 64 + p] = (f32x2v){xr, xi};
    float Lr = l16.x, Li = l16.y;
#pragma unroll
    for (int q = 0; q < 5; ++q) { const float nr = Lr * Lr - Li * Li, ni = 2.f * Lr * Li; Lr = nr; Li = ni; }
    __syncthreads();
    float cr = x0r, ci = x0i;
    for (int s = 0; s < sg; ++s) { const f32x2v t = tot[s * 64 + p]; const float nr = Lr * cr - Li * ci + t.x, ni = Lr * ci + Li * cr + t.y; cr = nr; ci = ni; }
    bf16_t* ap = A2 + ((size_t)g * 2048 + b * 256 + sg * 32) * 384 + p;
    float pr = 1.f, pi = 0.f;
#pragma unroll
    for (int q = 0; q < 32; ++q) { float Xr = pr * cr - pi * ci, Xi = pr * ci + pi * cr; if (q > 0) { Xr += lr[q - 1]; Xi += li[q - 1]; }
        ap[(size_t)q * 384] = f2bf(Xr); ap[(size_t)q * 384 + 64] = f2bf(Xi);
        const float nr = pr * l16.x - pi * l16.y, ni = pr * l16.y + pi * l16.x; pr = nr; pi = ni; }
    __syncthreads();
}

struct Args { const float* x; const float* w_in; const float* gmix; const float* w_out; const float* lre; const float* lim; const float* ldt; const float* sbre; const float* sbim; const float* scre; const float* scim; const float* sdsk; const float* w_glu; const float* meta; const float* gffn; const float* wrg; const float* brg; const float* wre; const float* bre; const float* wgate; const float* wup; const float* wdown; const float* gfin;
              float* out; unsigned char* ws; int ph_lo, ph_hi, li, pad; };
constexpr size_t MiB = 1u << 20;
constexpr size_t WS_CTL = 0, WS_WTIN = 2 * MiB, WS_WTOUT = 10 * MiB, WS_WGU = 12 * MiB, WS_WDT = 28 * MiB, WS_IDX = 52 * MiB, WS_WLO = 55 * MiB, WS_WHI = 58 * MiB, WS_RS = 61 * MiB,
                 WS_XN = 64 * MiB  , WS_MIXED = 128 * MiB  , WS_Z = 192 * MiB, WS_REST = 401 * MiB, WS_KV = 128 * MiB  ,
                 WS_A2 = 401 * MiB, WS_LOC = 425 * MiB, WS_YTOK = 441 * MiB, WS_W1T = 457 * MiB, WS_W2T = 459 * MiB, WS_WGLUT = 462 * MiB, WS_S5TAB = 463 * MiB, WS_CS = 464 * MiB, WS_ZM = 466 * MiB, WS_END = 467 * MiB;
static_assert(WS_Z + (size_t)T_REAL * NIN * 2 <= WS_REST, "ws map");

__global__ void __launch_bounds__(NWAVES * 64, 2) mega(Args args) {
    extern __shared__ __attribute__((aligned(16))) unsigned char lds_raw[];
    LAS unsigned char* lds = (LAS unsigned char*)lds_raw;
    volatile LAS unsigned* MISC = (volatile LAS unsigned*)(lds + MISC_OFF);
    LAS int* tab = (LAS int*)(lds + TAB_OFF); LAS int* utab = tab + 80;
    LAS int* ridx = (LAS int*)(lds + RIDX_OFF);
    const int tid = threadIdx.x, lane = tid & 63, wave = __builtin_amdgcn_readfirstlane(tid >> 6);
    const int G = gridDim.x;
    unsigned char* ws = args.ws;
    gu32* ctl = (gu32*)(ws + WS_CTL);
    bf16* WtIn = (bf16*)(ws + WS_WTIN); bf16* WtOut = (bf16*)(ws + WS_WTOUT); bf16* Wgu = (bf16*)(ws + WS_WGU); bf16* WdT = (bf16*)(ws + WS_WDT);
    int* IDX = (int*)(ws + WS_IDX); float* WLO = (float*)(ws + WS_WLO); float* WHI = (float*)(ws + WS_WHI); float* RSV = (float*)(ws + WS_RS);
    bf16* XN = (bf16*)(ws + WS_XN); bf16* RT = (bf16*)(ws + WS_XN); float* KV = (float*)(ws + WS_KV);
    bf16* A2 = (bf16*)(ws + WS_A2); float* LOC = (float*)(ws + WS_LOC); bf16* YTOK = (bf16*)(ws + WS_YTOK); bf16* W1T = (bf16*)(ws + WS_W1T); bf16* W2T = (bf16*)(ws + WS_W2T); bf16* WgluT = (bf16*)(ws + WS_WGLUT); float* CS = (float*)(ws + WS_CS); float* ZM = (float*)(ws + WS_ZM);
    S5Tabs TB{(f32x2v*)(ws + WS_S5TAB), (f32x2v*)(ws + WS_S5TAB + 16384), (f32x2v*)(ws + WS_S5TAB + 32768)}; bf16* H1B = (bf16*)(ws + WS_XN); bf16* MIXED = (bf16*)(ws + WS_MIXED); bf16* HB = (bf16*)(ws + WS_MIXED); bf16* Z = (bf16*)(ws + WS_Z); bf16* H2B = (bf16*)(ws + WS_Z);
    for (int u = tid; u < (LDS_BYTES - LDSCTL_OFF) / 4; u += NWAVES * 64) ((LAS unsigned*)(lds + LDSCTL_OFF))[u] = 0u;
    __syncthreads();
    XcdBarrier bar = xcd_barrier_post((unsigned*)(ctl + CW_BAR) + args.li * XCD_BAR_WORDS, MISC + 8);
    const int lo = args.ph_lo, hi = args.ph_hi;
    const int gw = blockIdx.x * NWAVES + wave, NGW = G * NWAVES;
#define IN(k) (lo <= (k) && (k) < hi)
#define BOTH(k) (IN(k) && IN((k) + 1))
    if (IN(0)) {
        LAS float* scr = (LAS float*)(lds + wave * 16384);
        constexpr int I_IN = (DM / 64) * (NIN / 32), I_OUT = (DM / 64) * (DM / 32), I_GU = 16 * 16 * 16, I_DN = 24 * 2 * 4 * 32;
        for (int it = gw; it < I_IN + I_OUT + I_GU + I_DN; it += NGW) {
            int r = it;
            if (r < I_IN) { const int nblk = NIN / 32, k0 = 64 * (r / nblk), n0 = 32 * (r % nblk); const float* W = args.w_in; const float* gs = args.gmix;
                tr_item([=](int kk, int nn) { const int ns = n0 + nn; int no = ns; float sc = 1.f; if (ns >= ZQ && ns < ZV) { const int sp = (ns - ZQ) & 127; no = (ns - sp) + (sp >> 1) + 64 * (sp & 1); if (ns >= ZK) sc = 0.08838834764831845f; }
                    return W[(size_t)(k0 + kk) * NIN + no] * gs[k0 + kk] * sc; }, WtIn + (size_t)n0 * DM + k0, DM, scr, lane); continue; } r -= I_IN;
            if (r < I_OUT) { const int nblk = DM / 32, k0 = 64 * (r / nblk), n0 = 32 * (r % nblk); const float* W = args.w_out;
                tr_item([=](int kk, int nn) { return W[(size_t)(k0 + kk) * DM + n0 + nn]; }, WtOut + (size_t)n0 * DM + k0, DM, scr, lane); continue; } r -= I_OUT;
            if (r < I_GU) { const int e = r >> 8, k0 = 64 * ((r >> 4) & 15), cb = r & 15; const float* Wg = args.wgate + (size_t)e * DM * 256; const float* Wu = args.wup + (size_t)e * DM * 256; const float* gs = args.gffn;
                tr_item([=](int kk, int nn) { const float* W = (nn >> 4) ? Wu : Wg; return W[(size_t)(k0 + kk) * 256 + cb * 16 + (nn & 15)] * gs[k0 + kk]; }, Wgu + ((size_t)e * 512 + cb * 32) * DM + k0, DM, scr, lane); continue; } r -= I_GU;
            { const int cls = r >> 8, half = (r >> 7) & 1, k0 = 64 * ((r >> 5) & 3), n0 = 32 * (r & 31);
              const int gi = cls / 6, p = cls - gi * 6; const int ea = p < 3 ? 0 : (p < 5 ? 1 : 2), eb = p < 3 ? p + 1 : (p < 5 ? p - 1 : 3); const int e = gi * 4 + (half ? eb : ea);
              const float* W = args.wdown + (size_t)e * 256 * DM;
              tr_item([=](int kk, int nn) { return W[(size_t)(k0 + kk) * DM + n0 + nn]; }, WdT + ((size_t)cls * 1024 + n0) * 512 + half * 256 + k0, 512, scr, lane); }
        }
        for (int it = gw; it < 32; it += NGW) { const int k0 = 64 * (it >> 3), n0 = 32 * (it & 7); const float* W = args.w_glu;
            tr_item([=](int kk, int nn) { return W[(size_t)(k0 + kk) * 256 + n0 + nn]; }, WgluT + (size_t)n0 * 256 + k0, 256, scr, lane); }
        for (int m = gw; m < T_REAL; m += NGW) rms_row_to_bf16(args.x + (size_t)m * DM, XN + (size_t)m * DM, lane);
        __syncthreads();
        for (int it = blockIdx.x; it < 256; it += G) s5_prep_item(it >> 4, it & 15, args.lre, args.lim, args.ldt, args.sbre, args.sbim, args.scre, args.scim, args.sdsk, W1T, W2T, TB, lds, tid);
        for (int i = blockIdx.x * 512 + tid; i < 24 * 32768; i += G * 512) IDX[i] = 0;
        for (int e = blockIdx.x * 512 + tid; e < SEQ * 64; e += G * 512) { const int sq = e >> 6, i = e & 63; const double ang = (double)(NMETA + sq) * c_invfreq[i];
            const double red = ang - 6.283185307179586476925 * rint(ang * 0.15915494309189533577); float sn, cs; sincosf((float)red, &sn, &cs); CS[(size_t)e * 2] = cs; CS[(size_t)e * 2 + 1] = sn; }
        if (BOTH(0)) xcd_barrier(bar);
    }
    if (IN(1)) {
        {
            LAS float* mx = (LAS float*)lds;
            for (int r = wave; r < NMETA; r += NWAVES) { const GAS f32x4* mr = (const GAS f32x4*)(args.meta + (size_t)r * DM) + lane; f32x4 v[4]; float ss = 0.f;
#pragma unroll
                for (int j = 0; j < 4; ++j) { v[j] = mr[64 * j]; ss += (v[j].x * v[j].x + v[j].y * v[j].y) + (v[j].z * v[j].z + v[j].w * v[j].w); }
                const float rstd = rsqrtf(wave_sum(ss) * (1.f / DM) + EPS);
#pragma unroll
                for (int j = 0; j < 4; ++j) *(LAS f32x4*)(mx + r * DM + lane * 4 + 256 * j) = v[j] * rstd; }
            __syncthreads();
            for (int n = gw; n < NIN; n += NGW) { float w[16];
#pragma unroll
                for (int j = 0; j < 2; ++j) { const v4u wv = *(const GAS v4u*)(WtIn + (size_t)n * DM + lane * 8 + 512 * j);
#pragma unroll
                    for (int q = 0; q < 4; ++q) { w[8 * j + 2 * q] = __uint_as_float(wv[q] << 16); w[8 * j + 2 * q + 1] = __uint_as_float(wv[q] & 0xffff0000u); } }
                for (int r = 0; r < NMETA; ++r) { float sacc = 0.f; asm volatile("" ::: "memory");
#pragma unroll
                    for (int j = 0; j < 2; ++j) { const f32x4 a0 = *(const LAS f32x4*)(mx + r * DM + lane * 8 + 512 * j), a1 = *(const LAS f32x4*)(mx + r * DM + lane * 8 + 512 * j + 4);
                        sacc += (a0.x * w[8 * j] + a0.y * w[8 * j + 1]) + (a0.z * w[8 * j + 2] + a0.w * w[8 * j + 3]) + (a1.x * w[8 * j + 4] + a1.y * w[8 * j + 5]) + (a1.z * w[8 * j + 6] + a1.w * w[8 * j + 7]); }
                    sacc = wave_sum(sacc); if (lane == 0) ZM[(size_t)r * NIN + n] = sacc; } }
            __syncthreads();
        }
        pg8::Gemm g{DM, DM, DM}; pg8::StaticOrder S; S.init(T_REAL, NIN, G, (int)blockIdx.x);
        S.A0 = (const char*)XN; S.B0 = (const char*)WtIn; S.strideA = (size_t)256 * DM * 2; S.strideB = (size_t)256 * DM * 2;
        pg8::EpiZ E{Z, NIN, A2, CS};
        pg8::gemm_phase<pg8::EpiZ, pg8::StaticOrder, PG8_ALIGN, PG8_SP2>(lds, g, S, E);
        if (BOTH(1)) xcd_barrier(bar);
    }
    int rit0, rits, rnit;
    if (G == 256) { if (blockIdx.x < 128) { rit0 = 512 + blockIdx.x; rits = 128; rnit = 2; } else { rit0 = blockIdx.x - 128; rits = 128; rnit = 4; } }
    else { rit0 = blockIdx.x; rits = G; rnit = blockIdx.x < 768 ? (767 - (int)blockIdx.x) / G + 1 : 0; }
    if (IN(2)) {
        { pg8::Gemm g{256, 384, 256}; pg8::S5Order S{G, (int)blockIdx.x, (const char*)(A2 + 128), (const char*)W1T, (size_t)2048 * 384 * 2, (size_t)256 * 256 * 2};
          pg8::EpiS5Loc E{LOC};
          pg8::gemm_phase<pg8::EpiS5Loc, pg8::S5Order, PG8_ALIGN, PG8_SP2>(lds, g, S, E); }
        __syncthreads();
        for (int q = 0; q < rnit; ++q) { const int item = rit0 + q * rits; const int bh = item >> 4, S = item & 15, b = bh / 6, h = bh - b * 6; const size_t row0 = (size_t)b * SEQ + S * 256;
            ret::loc_item(lds, Z + row0 * NIN + ZK + h * 128, Z + row0 * NIN + ZV + h * 128, NIN, ret::gamma_log2(h), KV + (size_t)item * 16384, tid, wave, lane); }
        for (int h = (int)blockIdx.x - (G - 6); h >= 0 && h < 6; h += G) {
            LAS float* kr = (LAS float*)lds; LAS float* vm = kr + 16 * 128; const float lg = ret::gamma_log2(h);
            for (int e = tid; e < 16 * 64; e += NWAVES * 64) { const int mt = e >> 6, i = e & 63; float sn, cs; sincosf((float)((double)mt * c_invfreq[i]), &sn, &cs);
                const float t1 = ZM[(size_t)mt * NIN + ZK + h * 128 + 2 * i], t2 = ZM[(size_t)mt * NIN + ZK + h * 128 + 2 * i + 1], dc = exp2f(lg * (float)(15 - mt));
                kr[mt * 128 + 2 * i] = (t1 * cs - t2 * sn) * dc; kr[mt * 128 + 2 * i + 1] = (t2 * cs + t1 * sn) * dc; }
            for (int e = tid; e < 16 * 128; e += NWAVES * 64) vm[e] = ZM[(size_t)(e >> 7) * NIN + ZV + h * 128 + (e & 127)];
            __syncthreads();
            for (int ed = tid; ed < 16384; ed += NWAVES * 64) { const int e = ed >> 7, d = ed & 127; float sacc = 0.f;
#pragma unroll
                for (int mt = 0; mt < NMETA; ++mt) sacc = fmaf(vm[mt * 128 + e], kr[mt * 128 + d], sacc);
                KV[(size_t)(768 + h) * 16384 + ed] = sacc; }
            __syncthreads(); }
        if (BOTH(2)) xcd_barrier(bar);
    }
    if (IN(3)) {
        for (int it = blockIdx.x; it < 128; it += G) { const int b = it >> 4, g = it & 15; const float* zm = ZM + g * 16;
            s5_scan_item(b, g, LOC, A2, TB, [=](int j, int h) { return zm[(size_t)j * NIN + h]; }, lds, tid); }
        for (int c = blockIdx.x * (NWAVES * 64) + tid; c < 48 * 16384; c += G * NWAVES * 64) { const int bh = c >> 14, ed = c & 16383, h = bh % 6;
            const float g256 = exp2f(256.f * ret::gamma_log2(h)); float r = KV[(size_t)(768 + h) * 16384 + ed]; float l[16];
#pragma unroll
            for (int S = 0; S < 16; ++S) l[S] = KV[(size_t)(bh * 16 + S) * 16384 + ed];
#pragma unroll
            for (int S = 0; S < 16; ++S) { RT[(size_t)(bh * 16 + S) * 16384 + ed] = f2bf(r); r = g256 * r + l[S]; } }
        if (BOTH(3)) xcd_barrier(bar);
    }
    if (IN(4)) {
        { pg8::Gemm g{384, 384, 384}; pg8::S5Order S{G, (int)blockIdx.x, (const char*)A2, (const char*)W2T, (size_t)2048 * 384 * 2, (size_t)256 * 384 * 2};
          pg8::EpiS5Y E{YTOK};
          pg8::gemm_phase<pg8::EpiS5Y, pg8::S5Order, PG8_ALIGN, PG8_SP2>(lds, g, S, E); }
        __syncthreads();
        for (int q = 0; q < rnit; ++q) { const int item = rit0 + q * rits; const int bh = item >> 4, S = item & 15, b = bh / 6, h = bh - b * 6; const size_t row0 = (size_t)b * SEQ + S * 256; const bf16* zr = Z + row0 * NIN + h * 128;
            ret::out_item(lds, zr + ZQ, zr + ZK, zr + ZV, zr + ZG, NIN, RT + (size_t)item * 16384, ret::gamma_log2(h), MIXED + row0 * DM + 256 + h * 128, DM, tid, wave, lane); }
        if (BOTH(4)) xcd_barrier(bar);
    }
    if (IN(5)) {
        pg8::Gemm g{256, 256, 256}; pg8::StaticOrder S; S.init(T_REAL, 256, G, (int)blockIdx.x);
        S.A0 = (const char*)YTOK; S.B0 = (const char*)WgluT; S.strideA = (size_t)256 * 256 * 2; S.strideB = 0;
        pg8::EpiGlu E{YTOK, MIXED, DM};
        pg8::gemm_phase<pg8::EpiGlu, pg8::StaticOrder, PG8_ALIGN, PG8_SP2>(lds, g, S, E);
        if (BOTH(5)) xcd_barrier(bar);
    }
    if (IN(6)) {
        pg8::Gemm g{DM, DM, DM}; pg8::StaticOrder S; S.init(T_REAL, DM, G, (int)blockIdx.x);
        S.A0 = (const char*)MIXED; S.B0 = (const char*)WtOut; S.strideA = (size_t)256 * DM * 2; S.strideB = (size_t)256 * DM * 2;
        pg8::EpiRes2 E{args.x, H1B, DM};
        pg8::gemm_phase<pg8::EpiRes2, pg8::StaticOrder, PG8_ALIGN, PG8_SP2>(lds, g, S, E);
        if (BOTH(6)) xcd_barrier(bar);
    }
    if (IN(7)) {
        LAS float* wl = (LAS float*)lds;
        LAS int* s_cls = (LAS int*)(lds + 81920); LAS float* s_wlo = (LAS float*)(lds + 81920 + 512); LAS float* s_whi = (LAS float*)(lds + 81920 + 1024); LAS float* s_rs = (LAS float*)(lds + 81920 + 1536);
        LAS int* s_base = (LAS int*)(lds + 81920 + 2048);
        for (int k = tid; k < DM; k += NWAVES * 64) {
            const float4 w = *(const float4*)(args.wrg + (size_t)k * 4); wl[0 * DM + k] = w.x; wl[1 * DM + k] = w.y; wl[2 * DM + k] = w.z; wl[3 * DM + k] = w.w;
#pragma unroll
            for (int g = 0; g < 4; ++g) { const float4 we = *(const float4*)(args.wre + ((size_t)g * DM + k) * 4); wl[(4 + 4 * g) * DM + k] = we.x; wl[(5 + 4 * g) * DM + k] = we.y; wl[(6 + 4 * g) * DM + k] = we.z; wl[(7 + 4 * g) * DM + k] = we.w; }
        }
        __syncthreads();
        for (int t0 = blockIdx.x * 128; t0 < T_REAL; t0 += G * 128) {
            for (int q = 0; q < 8; ++q) {
                const int tl = wave * 16 + q * 2;
                float a[2][16]; float rsv[2];
#pragma unroll
                for (int tk = 0; tk < 2; ++tk) { float ss = 0.f;
#pragma unroll
                    for (int j = 0; j < 2; ++j) { const v4u hv = *(const GAS v4u*)(H1B + (size_t)(t0 + tl + tk) * DM + lane * 8 + 512 * j);
#pragma unroll
                        for (int q = 0; q < 4; ++q) { const float lo_ = __uint_as_float(hv[q] << 16), hi_ = __uint_as_float(hv[q] & 0xffff0000u); a[tk][8 * j + 2 * q] = lo_; a[tk][8 * j + 2 * q + 1] = hi_; ss += lo_ * lo_ + hi_ * hi_; } }
                    rsv[tk] = rsqrtf(wave_sum(ss) * (1.f / DM) + EPS); }
#pragma unroll
                for (int j = 0; j < 2; ++j)
#pragma unroll
                    for (int q = 0; q < 2; ++q) { const f32x4 gv = *(const GAS f32x4*)(args.gffn + lane * 8 + 512 * j + 4 * q);
#pragma unroll
                        for (int i = 0; i < 4; ++i) { a[0][8 * j + 4 * q + i] *= gv[i] * rsv[0]; a[1][8 * j + 4 * q + i] *= gv[i] * rsv[1]; } }
                float lg[2][20];
#pragma unroll
                for (int c = 0; c < 20; ++c) {
                    float s0 = 0.f, s1 = 0.f;
#pragma unroll
                    for (int j = 0; j < 2; ++j)
#pragma unroll
                        for (int q = 0; q < 2; ++q) { const f32x4 w = *(const LAS f32x4*)(wl + c * DM + lane * 8 + 512 * j + 4 * q);
#pragma unroll
                            for (int i = 0; i < 4; ++i) { s0 = fmaf(a[0][8 * j + 4 * q + i], w[i], s0); s1 = fmaf(a[1][8 * j + 4 * q + i], w[i], s1); } }
                    lg[0][c] = wave_sum(s0); lg[1][c] = wave_sum(s1);
                }
                if (lane < 2) {
                    float L[20];
#pragma unroll
                    for (int c = 0; c < 20; ++c) L[c] = lane ? lg[1][c] : lg[0][c];
                    float l4[4];
#pragma unroll
                    for (int c = 0; c < 4; ++c) l4[c] = L[c] + args.brg[c];
                    int gi = 0; float gm = l4[0];
#pragma unroll
                    for (int g = 1; g < 4; ++g) if (l4[g] > gm) { gm = l4[g]; gi = g; }
                    float den = 0.f;
#pragma unroll
                    for (int g = 0; g < 4; ++g) den += expf(l4[g] - gm);
                    const float gwt = 1.f / den;
                    float v[4];
#pragma unroll
                    for (int e = 0; e < 4; ++e) v[e] = sel4(L[4 + e], L[8 + e], L[12 + e], L[16 + e], gi) + args.bre[gi * 4 + e];
                    int i1 = 0; float m1 = v[0];
#pragma unroll
                    for (int e = 1; e < 4; ++e) if (v[e] > m1) { m1 = v[e]; i1 = e; }
                    int i2 = -1; float m2 = -3.0e38f;
#pragma unroll
                    for (int e = 0; e < 4; ++e) if (e != i1 && v[e] > m2) { m2 = v[e]; i2 = e; }
                    const float w1 = 1.f / (1.f + expf(m2 - m1)), w2 = 1.f - w1;
                    const int ea = i1 < i2 ? i1 : i2, eb = i1 < i2 ? i2 : i1;
                    const int p = ea == 0 ? eb - 1 : (ea == 1 ? eb + 1 : 5);
                    s_cls[tl + lane] = gi * 6 + p; s_wlo[tl + lane] = gwt * (i1 < i2 ? w1 : w2); s_whi[tl + lane] = gwt * (i1 < i2 ? w2 : w1); s_rs[tl + lane] = lane ? rsv[1] : rsv[0];
                }
            }
            __syncthreads();
            if (tid < 24) { int n = 0; for (int j = 0; j < 128; ++j) n += (s_cls[j] == tid) ? 1 : 0; s_base[tid] = n ? (int)__hip_atomic_fetch_add(ctl + CW_CNT + tid, (unsigned)n, RLX_AGENT) : 0; }
            __syncthreads();
            if (tid < 128) { const int c = s_cls[tid]; int rk = 0; for (int j = 0; j < tid; ++j) rk += (s_cls[j] == c) ? 1 : 0; const size_t pos = (size_t)c * 32768 + s_base[c] + rk;
                IDX[pos] = t0 + tid; WLO[pos] = s_wlo[tid]; WHI[pos] = s_whi[tid]; RSV[pos] = s_rs[tid]; }
            __syncthreads();
        }
        if (BOTH(7)) xcd_barrier(bar);
    }
    if (IN(8) || IN(9)) {
        if (tid == 0) { int tb = 0; for (int c = 0; c < 24; ++c) { const int n = (int)__hip_atomic_load(ctl + CW_CNT + c, RLX_AGENT); tab[c] = n; tab[32 + c] = tb; tb += (n + 255) >> 8; } tab[32 + 24] = tb; tab[64] = tb;
            for (int i = 0; i < MAXU; ++i) { const int L = i * G + (int)blockIdx.x; int t = -1, pn = 0, cls = 0, pos0 = 0;
                if (L < tb * 4) { t = L >> 2; pn = L & 3; for (int q = 1; q < 24; ++q) cls += (t >= tab[32 + q]) ? 1 : 0; pos0 = 256 * (t - tab[32 + cls]); }
                utab[i * 4] = t; utab[i * 4 + 1] = pn; utab[i * 4 + 2] = cls; utab[i * 4 + 3] = pos0; } }
        __syncthreads();
    }
    if (IN(8)) {
        pg8::MoeOrder S{utab, 0, (const char*)H1B, (const char*)Wgu};
        for (int i = 0; i < MAXU; ++i) { pg8::Unit u; if (!S.next(i, u)) break; if (tid < 256) ridx[i * 256 + tid] = IDX[(size_t)u.aux0 * 32768 + u.aux1 + tid]; }
        __syncthreads();
        pg8::Gemm g{DM, DM, DM};
        pg8::EpiMoeH E{HB, WLO, WHI, RSV};
        pg8::gemm_phase<pg8::EpiMoeH, pg8::MoeOrder, PG8_ALIGN, PG8_SP2, true>(lds, g, S, E, ridx);
        if (BOTH(8)) xcd_barrier(bar);
    }
    if (IN(9)) {
        pg8::MoeOrder S{utab, 1, (const char*)HB, (const char*)WdT};
        pg8::Gemm g{512, 512, 512};
        pg8::EpiMoeDown E{H1B, H2B, IDX, tab};
        pg8::gemm_phase<pg8::EpiMoeDown, pg8::MoeOrder, PG8_ALIGN, PG8_SP2>(lds, g, S, E);
        if (BOTH(9)) xcd_barrier(bar);
    }
    if (IN(10)) {
        for (int m = gw; m < T_REAL; m += NGW) {
            float v[16]; float ss = 0.f;
#pragma unroll
            for (int j = 0; j < 2; ++j) { const v4u hv = *(const GAS v4u*)(H2B + (size_t)m * DM + lane * 8 + 512 * j);
#pragma unroll
                for (int q = 0; q < 4; ++q) { const float lo_ = __uint_as_float(hv[q] << 16), hi_ = __uint_as_float(hv[q] & 0xffff0000u); v[8 * j + 2 * q] = lo_; v[8 * j + 2 * q + 1] = hi_; ss += lo_ * lo_ + hi_ * hi_; } }
            const float rstd = rsqrtf(wave_sum(ss) * (1.f / DM) + EPS);
#pragma unroll
            for (int j = 0; j < 2; ++j)
#pragma unroll
                for (int q = 0; q < 2; ++q) { const f32x4 gv = *(const GAS f32x4*)(args.gfin + lane * 8 + 512 * j + 4 * q); f32x4 o;
#pragma unroll
                    for (int i = 0; i < 4; ++i) o[i] = v[8 * j + 4 * q + i] * rstd * gv[i];
                    *(GAS f32x4*)(args.out + (size_t)m * DM + lane * 8 + 512 * j + 4 * q) = o; }
        }
    }
#undef IN
#undef BOTH
}

extern "C" void kernel_launch(void* const* d_in, const int* in_sizes, int n_in, void* d_out, int out_size, void* d_ws, size_t ws_size, hipStream_t stream) {
    (void)in_sizes; (void)n_in; (void)out_size;
    unsigned char* ws = (unsigned char*)d_ws;
    static int grid = 0;
    if (grid == 0) {
        int dev = 0, cus = 0, per_cu = 0;
        (void)hipGetDevice(&dev); (void)hipDeviceGetAttribute(&cus, hipDeviceAttributeMultiprocessorCount, dev);
        (void)hipFuncSetAttribute((const void*)mega, hipFuncAttributeMaxDynamicSharedMemorySize, LDS_BYTES);
        (void)hipOccupancyMaxActiveBlocksPerMultiprocessor(&per_cu, (const void*)mega, NWAVES * 64, LDS_BYTES);
        (void)hipGetLastError();
        if (per_cu < 1) fprintf(stderr, "kernel_launch: occupancy query reports %d blocks per CU\n", per_cu);
        grid = cus > 0 ? cus : 256;
        if (WS_END > ws_size) fprintf(stderr, "kernel_launch: workspace too small: need %zu have %zu\n", (size_t)WS_END, ws_size);
    }
    (void)hipMemsetAsync(ws + WS_CTL, 0, CTL_BYTES, stream);
    Args a{};
    a.x = (const float*)d_in[0]; a.meta = (const float*)d_in[1]; a.gmix = (const float*)d_in[2]; a.w_in = (const float*)d_in[3];
    a.lre = (const float*)d_in[4]; a.lim = (const float*)d_in[5]; a.ldt = (const float*)d_in[6]; a.sbre = (const float*)d_in[7]; a.sbim = (const float*)d_in[8];
    a.scre = (const float*)d_in[9]; a.scim = (const float*)d_in[10]; a.sdsk = (const float*)d_in[11]; a.w_glu = (const float*)d_in[12]; a.w_out = (const float*)d_in[13];
    a.gffn = (const float*)d_in[14]; a.wrg = (const float*)d_in[15]; a.brg = (const float*)d_in[16]; a.wre = (const float*)d_in[17]; a.bre = (const float*)d_in[18];
    a.wgate = (const float*)d_in[19]; a.wup = (const float*)d_in[20]; a.wdown = (const float*)d_in[21]; a.gfin = (const float*)d_in[22];
    a.out = (float*)d_out; a.ws = ws; a.ph_lo = 0; a.ph_hi = 11; a.li = 0;
    hipLaunchKernelGGL(mega, dim3(grid), dim3(NWAVES * 64), LDS_BYTES, stream, a);
}
```
